# Optimizing an MI355X kernel written in HIP

```python
import math
import jax, jax.numpy as jnp
from jax import lax
import numpy as np

D_MODEL = 2048
BATCH = 8
SEQ = 4096
DEPTH = 4

SSM_WIDTH = D_MODEL // 2
SSM_GROUP = 16
SSM_GROUPS = SSM_WIDTH // SSM_GROUP
SSM_STATE = 64
ATTN_WIDTH = D_MODEL - SSM_WIDTH
HEAD_DIM = 64
ATTN_HEADS = ATTN_WIDTH // (2 * HEAD_DIM)
MIX_WIDTH = SSM_WIDTH + ATTN_WIDTH
IN_WIDTH = 2 * SSM_WIDTH + 4 * ATTN_WIDTH
ROPE_THETA = 10000.0
Q_BLOCK = 128
NORM_EPS = 1e-6
DT_MIN = 1e-3
DT_MAX = 1e-1

kernel_name = "hybrid_s5_diffattn_adaln_trunk"


def rms_norm(x, g):
    xf = x.astype(jnp.float32)
    y = xf * lax.rsqrt(jnp.mean(xf * xf, axis=-1, keepdims=True) + NORM_EPS)
    return (y * g.astype(jnp.float32)).astype(x.dtype)


def rope_tables(positions):
    half = HEAD_DIM // 2
    inv_freq = ROPE_THETA ** (-jnp.arange(half, dtype=jnp.float32) / half)
    ang = positions.astype(jnp.float32)[..., None] * inv_freq
    return jnp.cos(ang)[:, :, None, None, :], jnp.sin(ang)[:, :, None, None, :]


def apply_rope(t, cos, sin):
    half = HEAD_DIM // 2
    tf = t.astype(jnp.float32)
    t1, t2 = tf[..., :half], tf[..., half:]
    return jnp.concatenate([t1 * cos - t2 * sin, t2 * cos + t1 * sin], axis=-1).astype(t.dtype)


def s5_mixer(u, a_re, a_im, b_re, b_im, c_re, c_im, d_skip, log_step, w_glu, b_glu):
    bsz, s = u.shape[0], u.shape[1]
    uf = u.astype(jnp.float32).reshape(bsz, s, SSM_GROUPS, SSM_GROUP)
    lam = lax.complex(a_re.astype(jnp.float32), a_im.astype(jnp.float32))
    step = jnp.exp(log_step.astype(jnp.float32))[:, None]
    a_bar = jnp.exp(lam * step)
    b_mat = lax.complex(b_re.astype(jnp.float32), b_im.astype(jnp.float32))
    b_bar = ((a_bar - 1.0) / lam)[..., None] * b_mat
    bu = jnp.einsum('gnp,bsgp->bsgn', b_bar, uf)
    a_seq = jnp.broadcast_to(a_bar, (1, s, SSM_GROUPS, SSM_STATE))

    def combine(left, right):
        a_l, b_l = left
        a_r, b_r = right
        return a_r * a_l, a_r * b_l + b_r

    _, states = lax.associative_scan(combine, (a_seq, bu), axis=1)
    c_mat = lax.complex(c_re.astype(jnp.float32), c_im.astype(jnp.float32))
    y = jnp.einsum('gpn,bsgn->bsgp', c_mat, states).real + d_skip.astype(jnp.float32) * uf
    y = jax.nn.gelu(y.reshape(bsz, s, SSM_WIDTH))
    ab = y @ w_glu.astype(jnp.float32) + b_glu.astype(jnp.float32)
    out = ab[..., :SSM_WIDTH] * jax.nn.sigmoid(ab[..., SSM_WIDTH:])
    return out.astype(u.dtype)


def diff_attention(q, k, v, lam, sub_g, lambda_init):
    bsz, s = q.shape[0], q.shape[1]
    nblk = s // Q_BLOCK
    scale = HEAD_DIM ** -0.5
    qb = q.reshape(bsz, nblk, Q_BLOCK, ATTN_HEADS, 2, HEAD_DIM).transpose(1, 0, 2, 3, 4, 5)
    vf = v.astype(jnp.float32)
    key_pos = jnp.arange(s)

    def block(args):
        q_blk, i = args
        sc = jnp.einsum('bqhmd,bkhmd->bhmqk', q_blk, k,
                        preferred_element_type=jnp.float32) * scale
        q_pos = i * Q_BLOCK + jnp.arange(Q_BLOCK)
        mask = key_pos[None, :] <= q_pos[:, None]
        sc = jnp.where(mask, sc, -jnp.inf)
        p = jax.nn.softmax(sc, axis=-1)
        w = p[:, :, 0] - lam * p[:, :, 1]
        return jnp.einsum('bhqk,bkhe->bqhe', w, vf)

    out = lax.map(block, (qb, jnp.arange(nblk)))
    out = out.transpose(1, 0, 2, 3, 4).reshape(bsz, s, ATTN_HEADS, 2 * HEAD_DIM)
    out = rms_norm(out, sub_g) * (1.0 - lambda_init)
    return out.astype(v.dtype)


def setup_inputs(seed: int = 0) -> dict:
    key = jax.random.key(seed)
    ks = jax.random.split(key, 24)
    f32 = jnp.float32
    x = jax.random.normal(ks[0], (BATCH, SEQ, D_MODEL), f32)
    c = jax.random.normal(ks[1], (BATCH, D_MODEL), f32)
    offset = jax.random.randint(ks[2], (BATCH, 1), 0, 2048, dtype=jnp.int32)
    positions = (offset + jnp.arange(SEQ, dtype=jnp.int32)[None, :]).astype(jnp.int32)
    norm_g = 1.0 + 0.02 * jax.random.normal(ks[3], (DEPTH, D_MODEL), f32)
    w_ada = 0.5 * D_MODEL ** -0.5 * jax.random.normal(ks[4], (DEPTH, D_MODEL, 3 * D_MODEL), f32)
    b_ada = 0.02 * jax.random.normal(ks[5], (DEPTH, 3 * D_MODEL), f32)
    w_in = D_MODEL ** -0.5 * jax.random.normal(ks[6], (DEPTH, D_MODEL, IN_WIDTH), f32)
    w_out = MIX_WIDTH ** -0.5 * jax.random.normal(ks[7], (DEPTH, MIX_WIDTH, D_MODEL), f32)
    ssm_a_re = -0.5 + 0.01 * jax.random.normal(ks[8], (DEPTH, SSM_GROUPS, SSM_STATE), f32)
    ssm_a_im = (math.pi * jnp.arange(SSM_STATE, dtype=f32))[None, None, :] \
        + 0.01 * jax.random.normal(ks[9], (DEPTH, SSM_GROUPS, SSM_STATE), f32)
    ssm_b_re = (2 * SSM_GROUP) ** -0.5 * jax.random.normal(ks[10], (DEPTH, SSM_GROUPS, SSM_STATE, SSM_GROUP), f32)
    ssm_b_im = (2 * SSM_GROUP) ** -0.5 * jax.random.normal(ks[11], (DEPTH, SSM_GROUPS, SSM_STATE, SSM_GROUP), f32)
    ssm_c_re = (2 * SSM_STATE) ** -0.5 * jax.random.normal(ks[12], (DEPTH, SSM_GROUPS, SSM_GROUP, SSM_STATE), f32)
    ssm_c_im = (2 * SSM_STATE) ** -0.5 * jax.random.normal(ks[13], (DEPTH, SSM_GROUPS, SSM_GROUP, SSM_STATE), f32)
    ssm_d = jax.random.normal(ks[14], (DEPTH, SSM_GROUPS, SSM_GROUP), f32)
    ssm_log_step = jax.random.uniform(ks[15], (DEPTH, SSM_GROUPS), f32,
                                      minval=math.log(DT_MIN), maxval=math.log(DT_MAX))
    w_glu = SSM_WIDTH ** -0.5 * jax.random.normal(ks[16], (DEPTH, SSM_WIDTH, 2 * SSM_WIDTH), f32)
    b_glu = 0.02 * jax.random.normal(ks[17], (DEPTH, 2 * SSM_WIDTH), f32)
    lam_q1 = 0.1 * jax.random.normal(ks[18], (DEPTH, HEAD_DIM), f32)
    lam_k1 = 0.1 * jax.random.normal(ks[19], (DEPTH, HEAD_DIM), f32)
    lam_q2 = 0.1 * jax.random.normal(ks[20], (DEPTH, HEAD_DIM), f32)
    lam_k2 = 0.1 * jax.random.normal(ks[21], (DEPTH, HEAD_DIM), f32)
    sub_g = 1.0 + 0.02 * jax.random.normal(ks[22], (DEPTH, 2 * HEAD_DIM), f32)
    final_g = 1.0 + 0.02 * jax.random.normal(ks[23], (D_MODEL,), f32)
    return {"x": x, "c": c, "positions": positions, "norm_g": norm_g, "w_ada": w_ada, "b_ada": b_ada,
            "w_in": w_in, "w_out": w_out, "ssm_a_re": ssm_a_re, "ssm_a_im": ssm_a_im,
            "ssm_b_re": ssm_b_re, "ssm_b_im": ssm_b_im, "ssm_c_re": ssm_c_re, "ssm_c_im": ssm_c_im,
            "ssm_d": ssm_d, "ssm_log_step": ssm_log_step, "w_glu": w_glu, "b_glu": b_glu,
            "lam_q1": lam_q1, "lam_k1": lam_k1, "lam_q2": lam_q2, "lam_k2": lam_k2,
            "sub_g": sub_g, "final_g": final_g}


def reference(x, c, positions, norm_g, w_ada, b_ada, w_in, w_out, ssm_a_re, ssm_a_im,
              ssm_b_re, ssm_b_im, ssm_c_re, ssm_c_im, ssm_d, ssm_log_step, w_glu, b_glu,
              lam_q1, lam_k1, lam_q2, lam_k2, sub_g, final_g):
    bsz, s = x.shape[0], x.shape[1]
    cos, sin = rope_tables(positions)
    c_act = jax.nn.silu(c)
    splits = [SSM_WIDTH, 2 * SSM_WIDTH, 2 * SSM_WIDTH + ATTN_WIDTH,
              2 * SSM_WIDTH + 2 * ATTN_WIDTH, 2 * SSM_WIDTH + 3 * ATTN_WIDTH]
    for l in range(DEPTH):
        lambda_init = 0.8 - 0.6 * math.exp(-0.3 * l)
        mod = c_act @ w_ada[l] + b_ada[l]
        shift, scale, gate = jnp.split(mod, 3, axis=-1)
        h = rms_norm(x, norm_g[l]) * (1.0 + scale[:, None, :]) + shift[:, None, :]
        proj = h @ w_in[l]
        u, z_s, q, k, v, z_a = jnp.split(proj, splits, axis=-1)
        y_s = s5_mixer(u, ssm_a_re[l], ssm_a_im[l], ssm_b_re[l], ssm_b_im[l], ssm_c_re[l],
                       ssm_c_im[l], ssm_d[l], ssm_log_step[l], w_glu[l], b_glu[l]) * jax.nn.silu(z_s)
        q = apply_rope(q.reshape(bsz, s, ATTN_HEADS, 2, HEAD_DIM), cos, sin)
        k = apply_rope(k.reshape(bsz, s, ATTN_HEADS, 2, HEAD_DIM), cos, sin)
        v = v.reshape(bsz, s, ATTN_HEADS, 2 * HEAD_DIM)
        lam = (jnp.exp(jnp.sum(lam_q1[l].astype(jnp.float32) * lam_k1[l].astype(jnp.float32)))
               - jnp.exp(jnp.sum(lam_q2[l].astype(jnp.float32) * lam_k2[l].astype(jnp.float32)))
               + lambda_init)
        y_a = diff_attention(q, k, v, lam, sub_g[l], lambda_init).reshape(bsz, s, ATTN_WIDTH)
        y_a = y_a * jax.nn.silu(z_a)
        y = jnp.concatenate([y_s, y_a.astype(y_s.dtype)], axis=-1) @ w_out[l]
        x = x + gate[:, None, :] * y
    return rms_norm(x, final_g)
```

```cpp
#include <hip/hip_runtime.h>
#include <hip/hip_cooperative_groups.h>
#include <cstdio>
#include <cstdint>
namespace cg = cooperative_groups;
#define GASP __attribute__((address_space(1)))
constexpr int BATCH = 8, SEQ = 4096, DMODEL = 2048, NTOK = BATCH * SEQ, DEPTH = 4, INW = 6144;
constexpr int NWAVES = 8;
constexpr size_t MiB = 1u << 20;
constexpr size_t WS_MOD = 0;
constexpr size_t WS_ROPEC = 1 * MiB, WS_ROPES = 5 * MiB;
constexpr size_t WS_S5W = 10 * MiB, S5W_LAYER = 16 * MiB, S5W2_OFF = 4 * MiB;
constexpr size_t WS_WIN = 74 * MiB, WS_WOUT = 170 * MiB, WS_WGLU = 202 * MiB;
constexpr size_t WS_H = 218 * MiB;
constexpr size_t WS_A2 = 346 * MiB;
constexpr size_t WS_E = 474 * MiB;
constexpr size_t WS_ZS = 538 * MiB, WS_Q = 602 * MiB, WS_K = 666 * MiB, WS_V = 730 * MiB, WS_ZA = 794 * MiB, WS_BIAS = 858 * MiB, WS_END = 860 * MiB;
constexpr size_t WS_SS = 9 * MiB;
constexpr int LDS_BYTES = 135168;

namespace pg8 {
#define PG8_LAS __attribute__((address_space(3)))
typedef unsigned short bf16_t;
typedef short bf16x8 __attribute__((ext_vector_type(8)));
typedef float f32x4 __attribute__((ext_vector_type(4)));
typedef unsigned u32x4 __attribute__((ext_vector_type(4)));
constexpr int BM = 256, BK = 64, HALF = 128, HTB = HALF * BK * 2  , STAGE_BYTES = 8 * HTB, NXCD = 8, WGM = 8;

__host__ __device__ __forceinline__ int lds_byte(int r, int c) { const int st = (r >> 4) * 2 + (c >> 5), rr = r & 15, cc = c & 31, ob = rr * 64 + cc * 2; return st * 1024 + (ob ^ (((ob >> 9) & 1) << 5)); }
__host__ __device__ __forceinline__ void stage_rc(int b, int& R, int& C) { const int st = b / 1024, sb = b % 1024, swz = sb ^ (((sb >> 9) & 1) << 5); R = (st >> 1) * 16 + swz / 64; C = (st & 1) * 32 + (swz % 64) / 2; }
__host__ __device__ __forceinline__ int perm32(int rho) { const int n = rho >> 4, i = rho & 15; return 8 * (i >> 2) + 4 * n + (i & 3); }

struct Unit { int pm, pn; };
struct Gemm { const bf16_t* A; const bf16_t* Bt; int M, N, K, lda, ldb, grp_tiles, grp_brows; };

struct StaticOrder {
    int nM, nN, nwg, G, c;
    __host__ __device__ void init(int M, int N, int G_, int c_) { nM = M / BM; nN = N / BM; nwg = nM * nN; G = G_; c = c_; }
    __host__ __device__ bool next(int i, Unit& u) const {
        const long L = (long)i * G + c; if (L >= nwg) return false;
        int wgid = (int)L; { const int q = nwg / NXCD, r = nwg % NXCD, xcd = wgid % NXCD, off = wgid / NXCD; wgid = (xcd < r ? xcd * (q + 1) : r * (q + 1) + (xcd - r) * q) + off; }
        const int nig = WGM * nN, gid = wgid / nig, fm = gid * WGM, gsz = (nM - fm) < WGM ? (nM - fm) : WGM;
        u.pm = fm + ((wgid % nig) % gsz); u.pn = (wgid % nig) / gsz; return true;
    }
    __device__ __forceinline__ void a_ready(const Unit&) const {}
    __device__ __forceinline__ void done(const Unit&) const {}
};


__device__ __forceinline__ unsigned cvt_pk_bf16(float lo, float hi) { unsigned r; asm volatile("v_cvt_pk_bf16_f32 %0, %1, %2" : "=v"(r) : "v"(lo), "v"(hi)); return r; }
__device__ __forceinline__ u32x4 pack8(f32x4 a, f32x4 b) { u32x4 w; w.x = cvt_pk_bf16(a[0], a[1]); w.y = cvt_pk_bf16(a[2], a[3]); w.z = cvt_pk_bf16(b[0], b[1]); w.w = cvt_pk_bf16(b[2], b[3]); return w; }
__device__ __forceinline__ void unpack8(u32x4 w, f32x4& a, f32x4& b) {
    a[0] = __uint_as_float(w.x << 16); a[1] = __uint_as_float(w.x & 0xffff0000u); a[2] = __uint_as_float(w.y << 16); a[3] = __uint_as_float(w.y & 0xffff0000u);
    b[0] = __uint_as_float(w.z << 16); b[1] = __uint_as_float(w.z & 0xffff0000u); b[2] = __uint_as_float(w.w << 16); b[3] = __uint_as_float(w.w & 0xffff0000u); }
__device__ __forceinline__ float sigmoid_f(float x) { return __builtin_amdgcn_rcpf(1.f + __builtin_amdgcn_exp2f(-1.4426950408889634f * x)); }
__device__ __forceinline__ float silu_f(float x) { return x * sigmoid_f(x); }
__device__ __forceinline__ float gelu_tanh_f(float x) { return x * sigmoid_f(1.5957691216057308f * (x + 0.044715f * x * x * x)); }
__device__ __forceinline__ f32x4 silu4(f32x4 v) { return (f32x4){silu_f(v[0]), silu_f(v[1]), silu_f(v[2]), silu_f(v[3])}; }
__device__ __forceinline__ f32x4 gelu4(f32x4 v) { return (f32x4){gelu_tanh_f(v[0]), gelu_tanh_f(v[1]), gelu_tanh_f(v[2]), gelu_tanh_f(v[3])}; }
__device__ __forceinline__ f32x4 sigm4(f32x4 v) { return (f32x4){sigmoid_f(v[0]), sigmoid_f(v[1]), sigmoid_f(v[2]), sigmoid_f(v[3])}; }

constexpr float QK_C2 = 0.125f * 1.4426950408889634f;
constexpr int A2_LD = 384;

struct EpiInProj {
    static constexpr bool PERM = true, AFTER_DRAIN = false;
    unsigned char* ws; int l;
    __device__ __forceinline__ void operator()(const f32x4 (&acc_)[2][2][4][2], const Unit& u, int wr, int wc, int fr, int fq) const {
        unsigned char* w = ws; asm volatile("" : "+s"(w));
        f32x4 acc[2][2][4][2];
        { const GASP float* ssp = (const GASP float*)(w + WS_SS) + (l & 1) * 32768 + u.pm * BM + wr * 64 + fr; const float* bp = (const float*)(w + WS_BIAS) + ((size_t)l * 8 + (u.pm >> 4)) * 6144 + u.pn * BM + 32 * wc + 8 * fq;
          f32x4 bs[2][2];
_Pragma("unroll") for (int bj = 0; bj < 2; ++bj) _Pragma("unroll") for (int n = 0; n < 2; ++n) bs[bj][n] = *(const GASP f32x4*)(bp + bj * HALF + 4 * n);
          float sv[2][4];
_Pragma("unroll") for (int ai = 0; ai < 2; ++ai) _Pragma("unroll") for (int m = 0; m < 4; ++m) sv[ai][m] = ssp[ai * HALF + m * 16];
          asm volatile("" : "+v"(sv[0][0]), "+v"(sv[0][1]), "+v"(sv[0][2]), "+v"(sv[0][3]), "+v"(sv[1][0]), "+v"(sv[1][1]), "+v"(sv[1][2]), "+v"(sv[1][3]));
_Pragma("unroll") for (int ai = 0; ai < 2; ++ai) _Pragma("unroll") for (int m = 0; m < 4; ++m) { const float rr = __builtin_amdgcn_rsqf(sv[ai][m] * (1.f / 2048.f) + 1e-6f);
_Pragma("unroll") for (int bj = 0; bj < 2; ++bj) _Pragma("unroll") for (int n = 0; n < 2; ++n) acc[ai][bj][m][n] = acc_[ai][bj][m][n] * rr + bs[bj][n]; } }
        bf16_t* A2 = (bf16_t*)(w + WS_A2); const float* ropec = (const float*)(w + WS_ROPEC); const float* ropes = (const float*)(w + WS_ROPES);
        const int seg = u.pn >> 2, colt = (u.pn & 3) * 256, row0 = u.pm * BM + wr * 64 + fr;
        if (seg == 2 || seg == 3) {
            bf16_t* O = (bf16_t*)(w + ((seg == 2) ? WS_Q : WS_K)); const float sc = (seg == 2) ? QK_C2 : 1.f;
#pragma unroll
            for (int ai = 0; ai < 2; ++ai) {
                f32x4 tc0[4], tc1[4], ts0[4], ts1[4];
#pragma unroll
                for (int m = 0; m < 4; ++m) { const size_t tr = (size_t)(row0 + ai * HALF + m * 16) * 32 + 8 * fq;
                    tc0[m] = *(const GASP f32x4*)(ropec + tr); tc1[m] = *(const GASP f32x4*)(ropec + tr + 4); ts0[m] = *(const GASP f32x4*)(ropes + tr); ts1[m] = *(const GASP f32x4*)(ropes + tr + 4); }
#pragma unroll
                for (int m = 0; m < 4; ++m) { const int row = row0 + ai * HALF + m * 16;
                    const f32x4 c0 = tc0[m], c1 = tc1[m], s0 = ts0[m], s1 = ts1[m];
                    const f32x4 a0 = acc[ai][0][m][0], a1 = acc[ai][0][m][1], b0 = acc[ai][1][m][0], b1 = acc[ai][1][m][1];
                    const f32x4 o10 = (a0 * c0 - b0 * s0) * sc, o11 = (a1 * c1 - b1 * s1) * sc, o20 = (b0 * c0 + a0 * s0) * sc, o21 = (b1 * c1 + a1 * s1) * sc;
                    bf16_t* p = O + (size_t)row * 1024 + colt + 64 * wc + 8 * fq;
                    *(GASP u32x4*)p = pack8(o10, o11); *(GASP u32x4*)(p + 32) = pack8(o20, o21); } }
        } else if (seg == 0) {
#pragma unroll
            for (int ai = 0; ai < 2; ++ai)
#pragma unroll
                for (int m = 0; m < 4; ++m) { const int row = row0 + ai * HALF + m * 16;
#pragma unroll
                    for (int bj = 0; bj < 2; ++bj) { const int col = colt + bj * HALF + 32 * wc + 8 * fq, g = col >> 4, p0 = col & 15;
                        *(GASP u32x4*)(A2 + ((size_t)(g * 2048 + (row >> 4)) * A2_LD + (row & 15) * 16 + p0)) = pack8(acc[ai][bj][m][0], acc[ai][bj][m][1]); } }
        } else {
            bf16_t* O = (bf16_t*)(w + ((seg == 1) ? WS_ZS : (seg == 4) ? WS_V : WS_ZA)); const bool act = (seg != 4);
#pragma unroll
            for (int ai = 0; ai < 2; ++ai)
#pragma unroll
                for (int m = 0; m < 4; ++m) { const int row = row0 + ai * HALF + m * 16;
#pragma unroll
                    for (int bj = 0; bj < 2; ++bj) { f32x4 v0 = acc[ai][bj][m][0], v1 = acc[ai][bj][m][1];
                        if (act) { v0 = silu4(v0); v1 = silu4(v1); }
                        *(GASP u32x4*)(O + (size_t)row * 1024 + colt + bj * HALF + 32 * wc + 8 * fq) = pack8(v0, v1); } }
        }
    }
};
struct EpiS5P1 {
    static constexpr bool PERM = true, AFTER_DRAIN = false;
    unsigned char* ws;
    __device__ __forceinline__ void operator()(const f32x4 (&acc)[2][2][4][2], const Unit& u, int wr, int wc, int fr, int fq) const {
        unsigned char* w = ws; asm volatile("" : "+s"(w)); float* E = (float*)(w + WS_H);
        const int row0 = u.pm * BM + wr * 64 + fr;
#pragma unroll
        for (int ai = 0; ai < 2; ++ai)
#pragma unroll
            for (int m = 0; m < 4; ++m) { float* p = E + (size_t)(row0 + ai * HALF + m * 16) * 128 + 32 * wc + 8 * fq;
                *(GASP f32x4*)p = acc[ai][0][m][0]; *(GASP f32x4*)(p + 4) = acc[ai][0][m][1]; }
    }
};
struct EpiS5P2 {
    static constexpr bool PERM = true, AFTER_DRAIN = false;
    unsigned char* ws;
    __device__ __forceinline__ void operator()(const f32x4 (&acc)[2][2][4][2], const Unit& u, int wr, int wc, int fr, int fq) const {
        unsigned char* w = ws; asm volatile("" : "+s"(w)); bf16_t* YG = (bf16_t*)(w + WS_E);
        const int g = u.pm >> 3, crow0 = (u.pm & 7) * BM + wr * 64 + fr;
#pragma unroll
        for (int ai = 0; ai < 2; ++ai)
#pragma unroll
            for (int m = 0; m < 4; ++m) { const int crow = crow0 + ai * HALF + m * 16;
#pragma unroll
                for (int bj = 0; bj < 2; ++bj) { const int col = bj * HALF + 32 * wc + 8 * fq, t = col >> 4, p0 = col & 15;
                    *(GASP u32x4*)(YG + (size_t)(crow * 16 + t) * 1024 + g * 16 + p0) = pack8(gelu4(acc[ai][bj][m][0]), gelu4(acc[ai][bj][m][1])); } }
    }
};
struct EpiGlu {
    static constexpr bool PERM = true, AFTER_DRAIN = false;
    unsigned char* ws; const float* bias;
    __device__ __forceinline__ void operator()(const f32x4 (&acc)[2][2][4][2], const Unit& u, int wr, int wc, int fr, int fq) const {
        unsigned char* w = ws; asm volatile("" : "+s"(w)); bf16_t* YCAT = (bf16_t*)(w + WS_A2); const bf16_t* ZS = (const bf16_t*)(w + WS_ZS);
        const int row0 = u.pm * BM + wr * 64 + fr, col = u.pn * 128 + 32 * wc + 8 * fq;
        const f32x4 ba0 = *(const GASP f32x4*)(bias + col), ba1 = *(const GASP f32x4*)(bias + col + 4), bb0 = *(const GASP f32x4*)(bias + 1024 + col), bb1 = *(const GASP f32x4*)(bias + 1024 + col + 4);
        u32x4 zr[2][4];
#pragma unroll
        for (int ai = 0; ai < 2; ++ai)
#pragma unroll
            for (int m = 0; m < 4; ++m) zr[ai][m] = *(const GASP u32x4*)(ZS + (size_t)(row0 + ai * HALF + m * 16) * 1024 + col);
#pragma unroll
        for (int ai = 0; ai < 2; ++ai)
#pragma unroll
            for (int m = 0; m < 4; ++m) { const int row = row0 + ai * HALF + m * 16;
                f32x4 z0, z1; unpack8(zr[ai][m], z0, z1);
                const f32x4 o0 = (acc[ai][0][m][0] + ba0) * sigm4(acc[ai][1][m][0] + bb0) * z0, o1 = (acc[ai][0][m][1] + ba1) * sigm4(acc[ai][1][m][1] + bb1) * z1;
                *(GASP u32x4*)(YCAT + (size_t)row * 2048 + col) = pack8(o0, o1); }
    }
};
struct EpiOut {
    static constexpr bool PERM = true, AFTER_DRAIN = false;
    const float* xin; float* xout; unsigned char* ws; const float* ng_next; int l;
    __device__ __forceinline__ void operator()(const f32x4 (&acc)[2][2][4][2], const Unit& u, int wr, int wc, int fr, int fq) const {
        unsigned char* w = ws; asm volatile("" : "+s"(w));
        const float* modl = (const float*)(w + WS_MOD) + (size_t)l * 8 * 6144; const float* modn = modl + 8 * 6144;
        bf16_t* XG = (bf16_t*)(w + WS_H);
        const int row0 = u.pm * BM + wr * 64 + fr, b = u.pm >> 4; const bool nxt = l < 3;
        float part[2][4];
#pragma unroll
        for (int ai = 0; ai < 2; ++ai)
#pragma unroll
            for (int m = 0; m < 4; ++m) part[ai][m] = 0.f;
#pragma unroll
        for (int bj = 0; bj < 2; ++bj) { const int col = u.pn * BM + bj * HALF + 32 * wc + 8 * fq;
            const f32x4 g0 = *(const GASP f32x4*)(modl + (size_t)b * 6144 + 4096 + col), g1 = *(const GASP f32x4*)(modl + (size_t)b * 6144 + 4096 + col + 4);
            f32x4 gm0 = g0, gm1 = g1;
            if (nxt) { gm0 = *(const GASP f32x4*)(ng_next + col) * (*(const GASP f32x4*)(modn + (size_t)b * 6144 + 2048 + col) + 1.f); gm1 = *(const GASP f32x4*)(ng_next + col + 4) * (*(const GASP f32x4*)(modn + (size_t)b * 6144 + 2048 + col + 4) + 1.f); }
#pragma unroll
            for (int ai = 0; ai < 2; ++ai) {
                f32x4 xa[4], xb[4];
#pragma unroll
                for (int m = 0; m < 4; ++m) { const size_t off = (size_t)(row0 + ai * HALF + m * 16) * 2048 + col; xa[m] = *(const GASP f32x4*)(xin + off); xb[m] = *(const GASP f32x4*)(xin + off + 4); }
#pragma unroll
                for (int m = 0; m < 4; ++m) { const size_t off = (size_t)(row0 + ai * HALF + m * 16) * 2048 + col;
                    const f32x4 x0 = xa[m], x1 = xb[m];
                    const f32x4 y0 = x0 + g0 * acc[ai][bj][m][0], y1 = x1 + g1 * acc[ai][bj][m][1];
                    *(GASP f32x4*)(xout + off) = y0; *(GASP f32x4*)(xout + off + 4) = y1;
                    if (nxt) { part[ai][m] += (y0[0] * y0[0] + y0[1] * y0[1]) + (y0[2] * y0[2] + y0[3] * y0[3]) + (y1[0] * y1[0] + y1[1] * y1[1]) + (y1[2] * y1[2] + y1[3] * y1[3]);
                        *(GASP u32x4*)(XG + off) = pack8(y0 * gm0, y1 * gm1); } } } }
        if (nxt) { const int lane = fr + 16 * fq; float* ssn = (float*)(w + WS_SS) + ((l + 1) & 1) * 32768 + row0;
#pragma unroll
            for (int ai = 0; ai < 2; ++ai)
#pragma unroll
                for (int m = 0; m < 4; ++m) { float s = part[ai][m];
                    s += __int_as_float(__builtin_amdgcn_ds_bpermute((lane ^ 16) << 2, __float_as_int(s))); s += __int_as_float(__builtin_amdgcn_ds_bpermute((lane ^ 32) << 2, __float_as_int(s)));
                    if (fq == 0) (void)__builtin_amdgcn_global_atomic_fadd_f32((__attribute__((address_space(1))) float*)(ssn + ai * HALF + m * 16), s); } }
    }
};
template <class Epi, class Sched, bool ALIGN_EPI = false, bool SP2 = false>
__device__ __forceinline__ void gemm_phase(PG8_LAS unsigned char* lds, const Gemm g, const Sched& S, const Epi& E, const int tid) {
    const int wid = __builtin_amdgcn_readfirstlane(tid >> 6), lane = tid & 63, wr = wid >> 2, wc = wid & 3, fr = lane & 15, fq = lane >> 4;
    const int K = g.K, nt = K / BK;
    unsigned voffA[2], voffB[2];
#pragma unroll
    for (int i = 0; i < 2; ++i) { int R, C; stage_rc(tid * 16 + i * 8192, R, C); const int Rb = Epi::PERM ? ((R & ~31) + perm32(R & 31)) : R;
        voffA[i] = (unsigned)(R * g.lda + C) * 2u; voffB[i] = (unsigned)(Rb * g.ldb + C) * 2u; }
    const size_t kstep = (size_t)(BK * 2);
    const size_t hstepA = (size_t)HALF * g.lda * 2, hstepB = (size_t)HALF * g.ldb * 2;
    const unsigned ldsw = (unsigned)wid * 1024u;
    const int aoff = lds_byte(wr * 64 + fr, fq * 8), boff = lds_byte(wc * 32 + fr, fq * 8);
#define PG8_SA(b, h) (((b) * 2 + (h)) * HTB)
#define PG8_SB(b, h) ((4 + (b) * 2 + (h)) * HTB)
#define PG8_STAGE(bufoff, gbase, voff) do { _Pragma("unroll") for (int _i = 0; _i < 2; ++_i) \
        __builtin_amdgcn_global_load_lds((const unsigned*)((const char*)(gbase) + (voff)[_i]), (PG8_LAS unsigned*)(lds + (bufoff) + ldsw + _i * 8192), 16, 0, 0); } while (0)
#define PG8_LDA(dst, b, h) do { _Pragma("unroll") for (int m = 0; m < 4; ++m) _Pragma("unroll") for (int k = 0; k < 2; ++k) dst[m][k] = *(const PG8_LAS bf16x8*)(lds + PG8_SA(b, h) + aoff + m * 2048 + k * 1024); } while (0)
#define PG8_LDB(dst, b, h) do { _Pragma("unroll") for (int n = 0; n < 2; ++n) _Pragma("unroll") for (int k = 0; k < 2; ++k) dst[n][k] = *(const PG8_LAS bf16x8*)(lds + PG8_SB(b, h) + boff + n * 2048 + k * 1024); } while (0)
#define PG8_MMA(ai, bj, At, Bt) do { __builtin_amdgcn_s_setprio(1); _Pragma("unroll") for (int m = 0; m < 4; ++m) _Pragma("unroll") for (int n = 0; n < 2; ++n) _Pragma("unroll") for (int k = 0; k < 2; ++k) \
        acc[ai][bj][m][n] = __builtin_amdgcn_mfma_f32_16x16x32_bf16(Bt[n][k], At[m][k], acc[ai][bj][m][n], 0, 0, 0); __builtin_amdgcn_s_setprio(0); } while (0)
#define PG8_WAIT_V(n) asm volatile("s_waitcnt vmcnt(" #n ")" ::: "memory")
#define PG8_WAIT_L(n) asm volatile("s_waitcnt lgkmcnt(" #n ")" ::: "memory")
#define PG8_BAR __builtin_amdgcn_s_barrier()
#define PG8_SCHED __builtin_amdgcn_sched_barrier(0)
    Unit cur, nxt; int ui = 0;
    if (!S.next(0, cur)) return;
    f32x4 acc[2][2][4][2];
#pragma unroll
    for (int a = 0; a < 2; ++a)
#pragma unroll
        for (int b = 0; b < 2; ++b)
#pragma unroll
            for (int m = 0; m < 4; ++m)
#pragma unroll
                for (int n = 0; n < 2; ++n) acc[a][b][m][n] = (f32x4){0.f, 0.f, 0.f, 0.f};
    bf16x8 At[4][2], B0[2][2], B1[2][2];
    const char* cA = (const char*)g.A + (size_t)cur.pm * 2 * hstepA; const char* cB = (const char*)g.Bt + ((size_t)(cur.pm / g.grp_tiles) * g.grp_brows + (size_t)cur.pn * BM) * g.ldb * 2;
    S.a_ready(cur);
    if constexpr (SP2) {
        PG8_STAGE(PG8_SB(0, 0), cB, voffB); PG8_STAGE(PG8_SB(0, 1), cB + hstepB, voffB); PG8_STAGE(PG8_SA(0, 0), cA, voffA); PG8_STAGE(PG8_SA(0, 1), cA + hstepA, voffA);
        if (wr == 1) PG8_BAR;
        PG8_WAIT_V(2); PG8_BAR;
        PG8_STAGE(PG8_SB(1, 0), cB + kstep, voffB); PG8_STAGE(PG8_SA(1, 0), cA + kstep, voffA); PG8_STAGE(PG8_SB(1, 1), cB + hstepB + kstep, voffB);
        PG8_WAIT_V(6); PG8_BAR;
    } else {
        PG8_STAGE(PG8_SB(0, 0), cB, voffB); PG8_STAGE(PG8_SA(0, 0), cA, voffA); PG8_STAGE(PG8_SB(0, 1), cB + hstepB, voffB); PG8_STAGE(PG8_SA(0, 1), cA + hstepA, voffA);
        if (wr == 1) PG8_BAR;
        PG8_WAIT_V(4); PG8_BAR;
        PG8_STAGE(PG8_SB(1, 0), cB + kstep, voffB); PG8_STAGE(PG8_SA(1, 0), cA + kstep, voffA); PG8_STAGE(PG8_SB(1, 1), cB + hstepB + kstep, voffB);
        PG8_WAIT_V(6); PG8_BAR;
    }
    for (;;) {
        const bool has_next = S.next(ui + 1, nxt);
        const char* nA = has_next ? (const char*)g.A + (size_t)nxt.pm * 2 * hstepA : cA; const char* nB = has_next ? (const char*)g.Bt + ((size_t)(nxt.pm / g.grp_tiles) * g.grp_brows + (size_t)nxt.pn * BM) * g.ldb * 2 : cB;
        for (int t = 0; t < nt; t += 2) {
            const bool last = (t == nt - 2);
            const char* a1 = cA + (size_t)(t + 1) * kstep;
            const char* a2 = last ? nA : cA + (size_t)(t + 2) * kstep; const char* b2 = last ? nB : cB + (size_t)(t + 2) * kstep;
            const char* a3 = a2 + kstep; const char* b3 = b2 + kstep;
            if (last && has_next) S.a_ready(nxt);
            if constexpr (SP2) {
            PG8_LDB(B0, 0, 0); PG8_LDB(B1, 0, 1); PG8_SCHED; PG8_LDA(At, 0, 0); PG8_STAGE(PG8_SA(1, 1), a1 + hstepA, voffA);
            PG8_WAIT_V(8); PG8_WAIT_L(0); PG8_BAR; PG8_MMA(0, 0, At, B0); PG8_MMA(0, 1, At, B1); PG8_BAR; PG8_SCHED;
            PG8_LDA(At, 0, 1); PG8_STAGE(PG8_SB(0, 0), b2, voffB); PG8_STAGE(PG8_SB(0, 1), b2 + hstepB, voffB); PG8_STAGE(PG8_SA(0, 0), a2, voffA);
            PG8_WAIT_V(8); PG8_WAIT_L(0); PG8_BAR; PG8_MMA(1, 0, At, B0); PG8_MMA(1, 1, At, B1); PG8_BAR; PG8_SCHED;
            PG8_LDB(B0, 1, 0); PG8_LDB(B1, 1, 1); PG8_SCHED; PG8_LDA(At, 1, 0); PG8_STAGE(PG8_SA(0, 1), a2 + hstepA, voffA);
            PG8_WAIT_V(8); PG8_WAIT_L(0); PG8_BAR; PG8_MMA(0, 0, At, B0); PG8_MMA(0, 1, At, B1); PG8_BAR; PG8_SCHED;
            PG8_LDA(At, 1, 1); PG8_STAGE(PG8_SB(1, 0), b3, voffB); PG8_STAGE(PG8_SB(1, 1), b3 + hstepB, voffB); PG8_STAGE(PG8_SA(1, 0), a3, voffA);
            PG8_WAIT_V(8); PG8_WAIT_L(0); PG8_BAR; PG8_MMA(1, 0, At, B0); PG8_MMA(1, 1, At, B1); PG8_BAR; PG8_SCHED;
            } else {
            PG8_LDB(B0, 0, 0); PG8_SCHED; PG8_LDA(At, 0, 0); PG8_STAGE(PG8_SA(1, 1), a1 + hstepA, voffA);
            PG8_WAIT_L(8); PG8_BAR; PG8_WAIT_L(0); PG8_MMA(0, 0, At, B0); PG8_BAR; PG8_SCHED;
            PG8_LDB(B1, 0, 1); PG8_STAGE(PG8_SB(0, 0), b2, voffB);
            PG8_BAR; PG8_WAIT_L(0); PG8_MMA(0, 1, At, B1); PG8_BAR;
            PG8_LDA(At, 0, 1); PG8_STAGE(PG8_SA(0, 0), a2, voffA);
            PG8_BAR; PG8_WAIT_L(0); PG8_MMA(1, 0, At, B0); PG8_BAR; PG8_SCHED;
            PG8_STAGE(PG8_SB(0, 1), b2 + hstepB, voffB);
            PG8_WAIT_V(6); PG8_BAR; PG8_MMA(1, 1, At, B1); PG8_BAR;
            PG8_LDB(B0, 1, 0); PG8_SCHED; PG8_LDA(At, 1, 0); PG8_STAGE(PG8_SA(0, 1), a2 + hstepA, voffA);
            PG8_WAIT_L(8); PG8_BAR; PG8_WAIT_L(0); PG8_MMA(0, 0, At, B0); PG8_BAR; PG8_SCHED;
            PG8_LDB(B1, 1, 1); PG8_STAGE(PG8_SB(1, 0), b3, voffB);
            PG8_BAR; PG8_WAIT_L(0); PG8_MMA(0, 1, At, B1); PG8_BAR;
            PG8_LDA(At, 1, 1); PG8_STAGE(PG8_SA(1, 0), a3, voffA);
            PG8_BAR; PG8_WAIT_L(0); PG8_MMA(1, 0, At, B0); PG8_BAR; PG8_SCHED;
            PG8_STAGE(PG8_SB(1, 1), b3 + hstepB, voffB);
            PG8_WAIT_V(6); PG8_BAR; PG8_MMA(1, 1, At, B1); PG8_BAR;
            }
        }
        if constexpr (ALIGN_EPI) { if (wr == 0) PG8_BAR; }
        if constexpr (!Epi::AFTER_DRAIN) { int wr_e = wr, wc_e = wc, fr_e = fr, fq_e = fq; asm volatile("" : "+s"(wr_e), "+s"(wc_e), "+v"(fr_e), "+v"(fq_e)); E(acc, cur, wr_e, wc_e, fr_e, fq_e); S.done(cur); }
        if (!has_next) break;
#pragma unroll
        for (int a = 0; a < 2; ++a)
#pragma unroll
            for (int b = 0; b < 2; ++b)
#pragma unroll
                for (int m = 0; m < 4; ++m)
#pragma unroll
                    for (int n = 0; n < 2; ++n) acc[a][b][m][n] = (f32x4){0.f, 0.f, 0.f, 0.f};
        cur = nxt; cA = nA; cB = nB; ++ui;
        if constexpr (ALIGN_EPI) { if (wr == 1) PG8_BAR; }
    }
    PG8_WAIT_V(0);
    if constexpr (!ALIGN_EPI) { if (wr == 0) PG8_BAR; }
    PG8_BAR;
    if constexpr (Epi::AFTER_DRAIN) { E.fused(acc, cur, wr, wc, fr, fq, lds, wid, lane); S.done(cur); }
#undef PG8_SA
#undef PG8_SB
#undef PG8_STAGE
#undef PG8_LDA
#undef PG8_LDB
#undef PG8_MMA
#undef PG8_WAIT_V
#undef PG8_WAIT_L
#undef PG8_BAR
#undef PG8_SCHED
}
}
#include <hip/hip_bf16.h>
#include <cmath>
namespace attn_body {
using bf16=__hip_bfloat16;
using bf16x8=__attribute__((ext_vector_type(8)))short;
using s16x4=__attribute__((ext_vector_type(4)))short;
using f32x16=__attribute__((ext_vector_type(16)))float;
using u32x4=__attribute__((ext_vector_type(4)))unsigned;
constexpr int BATCH=8,NHEAD=16,SEQ=4096,D=64,DM=NHEAD*D;
constexpr int NW=8,QBLK=32,QB=QBLK*NW,KVBLK=64,NQB=SEQ/QB;
constexpr int ATTN_PITCH=DM, ATTN_UNIT_ROWS=QB;
__device__ __forceinline__ int crow(int r,int hi){return (r&3)+8*(r>>2)+4*hi;}
#define SBAR() __builtin_amdgcn_sched_barrier(0)
__device__ __forceinline__ void cmask(f32x16&p0,f32x16&p1,int jb,int qrel,int hi){
  const float NEG=-INFINITY; int kb=64*jb+4*hi;
  #pragma unroll
  for(int r=0;r<16;++r){int kv=kb+(r&3)+8*(r>>2); if(kv>qrel)p0[r]=NEG; if(kv+32>qrel)p1[r]=NEG;}
}

constexpr int NSLOT=3, SLOTB=8192;
constexpr int LDS_K=0, LDS_V=NSLOT*SLOTB, LDS_WS=2*NSLOT*SLOTB, LDS_OST=LDS_WS+NW*64*4, LDS_BYTES=LDS_OST+NW*4096;
constexpr float C2=0.125f*1.4426950408889634f;
__device__ __forceinline__ void glds16(const void*gsrc,unsigned lds_dst){unsigned keep;
  asm volatile("s_mov_b32 %0, m0\n\ts_mov_b32 m0, %2\n\ts_nop 0\n\tglobal_load_lds_dwordx4 %1, off\n\ts_mov_b32 m0, %0":"=&s"(keep):"v"(gsrc),"s"(lds_dst):"memory");}
__device__ __forceinline__ float max3f(float a,float b,float c){float r;asm("v_max3_f32 %0, %1, %2, %3":"=v"(r):"v"(a),"v"(b),"v"(c));return r;}
__device__ __forceinline__ float max2f(float a,float b){float r;asm("v_max_f32_e32 %0, %1, %2":"=v"(r):"v"(a),"v"(b));return r;}
__device__ __forceinline__ float fadd_s(float a,float b){float r;asm("v_add_f32_e32 %0, %1, %2":"=v"(r):"v"(a),"v"(b));return r;}
__device__ __forceinline__ float fsub_s(float a,float b){float r;asm("v_sub_f32_e32 %0, %1, %2":"=v"(r):"v"(a),"v"(b));return r;}
typedef float f32x2_t __attribute__((ext_vector_type(2))); typedef __bf16 bf16x2_t __attribute__((ext_vector_type(2)));
__device__ __forceinline__ unsigned cvtpk_s(float lo,float hi){f32x2_t v={lo,hi};bf16x2_t b=__builtin_convertvector(v,bf16x2_t);return __builtin_bit_cast(unsigned,b);}
#define WAIT_BAR(N) asm volatile("s_waitcnt vmcnt(" #N ") lgkmcnt(0)\n\ts_barrier":::"memory")

__device__ __forceinline__ void qkt(f32x16&p0,f32x16&p1,const char*Kslot,const bf16x8*qr,const f32x16&negm,int r32,int hi){
  const char*kb=Kslot+hi*1024+r32*16;
  #pragma unroll
  for(int d0=0;d0<4;++d0){
    const bf16x8 b0=*reinterpret_cast<const bf16x8*>(kb+d0*2048);
    const bf16x8 b1=*reinterpret_cast<const bf16x8*>(kb+d0*2048+512);
    if(d0==0){p0=__builtin_amdgcn_mfma_f32_32x32x16_bf16(b0,qr[0],negm,0,0,0);p1=__builtin_amdgcn_mfma_f32_32x32x16_bf16(b1,qr[0],negm,0,0,0);}
    else{p0=__builtin_amdgcn_mfma_f32_32x32x16_bf16(b0,qr[d0],p0,0,0,0);p1=__builtin_amdgcn_mfma_f32_32x32x16_bf16(b1,qr[d0],p1,0,0,0);}}
}
typedef __attribute__((address_space(3))) const char* lds_cptr;
typedef short v4i16_t __attribute__((ext_vector_type(4)));
__device__ __forceinline__ void kload8(bf16x8*kf,lds_cptr kp){
  kf[0]=*(const __attribute__((address_space(3))) bf16x8*)(kp);      kf[1]=*(const __attribute__((address_space(3))) bf16x8*)(kp+512);
  kf[2]=*(const __attribute__((address_space(3))) bf16x8*)(kp+2048); kf[3]=*(const __attribute__((address_space(3))) bf16x8*)(kp+2560);
  kf[4]=*(const __attribute__((address_space(3))) bf16x8*)(kp+4096); kf[5]=*(const __attribute__((address_space(3))) bf16x8*)(kp+4608);
  kf[6]=*(const __attribute__((address_space(3))) bf16x8*)(kp+6144); kf[7]=*(const __attribute__((address_space(3))) bf16x8*)(kp+6656);
}
__device__ __forceinline__ void kload2(bf16x8*kf,lds_cptr kp,int j){ kf[2*j]=*(const __attribute__((address_space(3))) bf16x8*)(kp+j*2048); kf[2*j+1]=*(const __attribute__((address_space(3))) bf16x8*)(kp+j*2048+512); }
__device__ __forceinline__ s16x4 vtr(lds_cptr p){ return __builtin_bit_cast(s16x4,__builtin_amdgcn_ds_read_tr16_b64_v4i16((__attribute__((address_space(3))) v4i16_t*)p)); }
__device__ __forceinline__ float rowmax(const f32x16&p0,const f32x16&p1){
  float a=max3f(p0[0],p0[1],p1[0]),b=max3f(p0[2],p0[3],p1[1]);a=max3f(a,p1[2],p1[3]);
  #pragma unroll
  for(int r=4;r<16;r+=4){a=max3f(a,p0[r],p0[r+1]);b=max3f(b,p0[r+2],p0[r+3]);a=max3f(a,p1[r],p1[r+1]);b=max3f(b,p1[r+2],p1[r+3]);}
  const float m=max2f(a,b);
  auto rr=__builtin_amdgcn_permlane32_swap(__float_as_uint(m),__float_as_uint(m),false,false);
  return max2f(__uint_as_float(rr[0]),__uint_as_float(rr[1]));
}
__device__ __forceinline__ void pv(f32x16*o,int vb,bf16x8 pa0,bf16x8 pa1,bf16x8 pa2,bf16x8 pa3){
  #pragma unroll
  for(int d0=0;d0<2;++d0){s16x4 lo[4],hi[4];
    #pragma unroll
    for(int ks=0;ks<4;++ks){
      asm volatile("ds_read_b64_tr_b16 %0,%1 offset:%c2":"=&v"(lo[ks]):"v"(vb),"i"(d0*4096+ks*1024):"memory");
      asm volatile("ds_read_b64_tr_b16 %0,%1 offset:%c2":"=&v"(hi[ks]):"v"(vb),"i"(d0*4096+ks*1024+512):"memory");}
    asm volatile("s_waitcnt lgkmcnt(0)":::"memory");SBAR();
    #define PK(k) (bf16x8){lo[k][0],lo[k][1],lo[k][2],lo[k][3],hi[k][0],hi[k][1],hi[k][2],hi[k][3]}
    o[d0]=__builtin_amdgcn_mfma_f32_32x32x16_bf16(pa0,PK(0),o[d0],0,0,0);
    o[d0]=__builtin_amdgcn_mfma_f32_32x32x16_bf16(pa1,PK(1),o[d0],0,0,0);
    o[d0]=__builtin_amdgcn_mfma_f32_32x32x16_bf16(pa2,PK(2),o[d0],0,0,0);
    o[d0]=__builtin_amdgcn_mfma_f32_32x32x16_bf16(pa3,PK(3),o[d0],0,0,0);
    #undef PK
  }
}

#ifndef ATTN_STORE16
#define ATTN_STORE16(p,v) (*(GASP u32x4*)(p)=(v))
#endif
template<int THRL> __device__ __forceinline__ void attn_unit(int b,int qc,int vc,int qb,const bf16*Q,const bf16*__restrict__ K,const bf16*__restrict__ V,bf16*O,char*shm,const int tid){
  const int lane=tid&63,r32=lane&31,hi=lane>>5; const int wid=__builtin_amdgcn_readfirstlane(tid>>6);
  const long rowbase=(long)b*SEQ; const int q0=qb*QB;
  const bf16*Qw=Q+(rowbase+q0+wid*QBLK)*DM+qc;
  const bf16*Kh=K+rowbase*DM+qc,*Vh=V+rowbase*DM+vc;
  const unsigned lds0=(unsigned)(uintptr_t)shm;
  float*wsf=(float*)(shm+LDS_WS)+wid*64;
  const bf16*ksrc=Kh+(long)lane*DM+wid*8;
  const bf16*vsrc=Vh+(long)(16*(wid&3)+(lane>>2))*DM+(wid>>2)*32+(lane&3)*8;
  const unsigned kdst=lds0+LDS_K+wid*1024, vdst=lds0+LDS_V+wid*1024;
  #define DMA_K(t,slot) glds16(ksrc+(long)(t)*KVBLK*DM,(unsigned)__builtin_amdgcn_readfirstlane(kdst+(slot)))
  #define DMA_V(t,slot) glds16(vsrc+(long)(t)*KVBLK*DM,(unsigned)__builtin_amdgcn_readfirstlane(vdst+(slot)))
  const int vb0=(int)(lds0+LDS_V)+((lane>>4)&1)*32+(lane&3)*8+(4*hi+((lane&15)>>2))*64;
  const char*Kbase=shm+LDS_K; bf16x8 kf[8];
  const lds_cptr shm3=(lds_cptr)shm; const lds_cptr kp0=shm3+LDS_K+hi*1024+r32*16; const lds_cptr vp0=shm3+LDS_V+((lane>>4)&1)*32+(lane&3)*8+(4*hi+((lane&15)>>2))*64;
  const int NT=(q0+QB)/KVBLK;
  DMA_K(0,0);DMA_V(0,0);DMA_K(1,SLOTB);
  bf16x8 qr[4];
  #pragma unroll
  for(int d0=0;d0<4;++d0)qr[d0]=*(const GASP bf16x8*)(&Qw[(long)r32*DM+d0*16+hi*8]);
  float zf_=0.f;asm volatile("":"+v"(zf_));float mhat=zf_,l_reg=zf_;f32x16 o[2],negm;
  #pragma unroll
  for(int r=0;r<16;++r){o[0][r]=zf_;o[1][r]=zf_;negm[r]=zf_;}
  asm volatile("":"+v"(negm));
  const int qrel=wid*QBLK+r32;
  #define CMASK(P0,P1,t) do{int jb_=(t)-(NT-4); if(jb_>=0)cmask(P0,P1,jb_,qrel,hi);}while(0)
  bool resc=false;
  #define START(P0,P1) do{ const float rm=rowmax(P0,P1); resc=false; \
    { const float dl=rm; mhat=fadd_s(mhat,dl); \
      _Pragma("unroll") for(int r=0;r<16;++r){P0[r]=fsub_s(P0[r],dl);P1[r]=fsub_s(P1[r],dl);} \
      _Pragma("unroll") for(int r=0;r<16;++r)negm[r]=-mhat; asm volatile("":"+v"(negm)); } \
    _Pragma("unroll") for(int r=0;r<16;++r)P0[r]=__builtin_amdgcn_exp2f(P0[r]); }while(0)
  #define RESC() do{ if(resc){ asm volatile("s_waitcnt lgkmcnt(0)":::"memory"); \
      _Pragma("unroll") for(int d_=0;d_<2;++d_) _Pragma("unroll") for(int r=0;r<16;++r)o[d_][r]*=wsf[crow(r,hi)]; } }while(0)
  f32x16 pA0,pA1,pB0,pB1;
  int sl_prev=0,sl_cur=0,sl_next=SLOTB;
  #define ROT() do{sl_prev=sl_cur;sl_cur=sl_next;sl_next=(sl_next==(NSLOT-1)*SLOTB)?0:sl_next+SLOTB;}while(0)
  DMA_K(2,2*SLOTB);
  WAIT_BAR(3);
  qkt(pA0,pA1,Kbase,qr,negm,r32,hi);asm volatile("s_nop 15\n\ts_nop 7":"+v"(pA0),"+v"(pA1));CMASK(pA0,pA1,0);
  START(pA0,pA1);
  _Pragma("unroll") for(int r=0;r<16;++r)pA1[r]=__builtin_amdgcn_exp2f(pA1[r]);
  WAIT_BAR(0);
  DMA_K(3,0);DMA_V(1,SLOTB);
  ROT();
  kload8(kf,kp0+sl_cur);
  WAIT_BAR(2);
  s16x4 vlo[8],vhi[8]; u32x4 pw0,pw1,pw2,pw3;
  #define PKW(P,B) cvtpk_s(P[B],P[B+1])
  #define PAF(k) __builtin_bit_cast(bf16x8,pw##k)
  #define VFR(i) (bf16x8){vlo[i][0],vlo[i][1],vlo[i][2],vlo[i][3],vhi[i][0],vhi[i][1],vhi[i][2],vhi[i][3]}
  #define PIN(x) asm volatile("":"+v"(x))
  #define MX3(a,b,c) __builtin_fmaxf(__builtin_fmaxf((a),(b)),(c))
  #define GAPA(MF,A0,A1,A2,A3,W0,W1,PW) do{ MF; sacc+=A0; sacc+=A1; sacc+=A2; sacc+=A3; PIN(sacc); W0; W1; PIN(PW); SBAR(); }while(0)
  #define EX(v) __builtin_amdgcn_exp2f(v)
  #define GAPB(MF,X,B) do{ MF; X[B]=EX(X[B]); X[B+1]=EX(X[B+1]); X[B+2]=EX(X[B+2]); X[B+3]=EX(X[B+3]); PIN(X); SBAR(); }while(0)
  #define VRD(i) do{ vlo[i]=vtr(vp_+(((i)>>2)*4096+((i)&3)*1024)); vhi[i]=vtr(vp_+(((i)>>2)*4096+((i)&3)*1024+512)); }while(0)
  #define KRD(G,j) do{ if(G){ kload2(kf,kp0+sl_next,j); SBAR(); } }while(0)
  #define STEP(C0,C1,P0,P1,t,GK,GV,GL) do{ SBAR(); \
    const lds_cptr vp_=vp0+sl_prev; \
    VRD(0); SBAR(); float sacc=(P0[0]+P0[1]); \
    GAPA(C0=__builtin_amdgcn_mfma_f32_32x32x16_bf16(kf[0],qr[0],negm,0,0,0), P0[2],P0[3],P0[4],P0[5],     pw0[0]=PKW(P0,0), pw0[1]=PKW(P0,2), pw0); \
    VRD(4); SBAR(); GAPA(C1=__builtin_amdgcn_mfma_f32_32x32x16_bf16(kf[1],qr[0],negm,0,0,0), P0[6],P0[7],P0[8],P0[9],     pw0[2]=PKW(P0,4), pw0[3]=PKW(P0,6), pw0); \
    VRD(1); SBAR(); GAPA(C0=__builtin_amdgcn_mfma_f32_32x32x16_bf16(kf[2],qr[1],C0,0,0,0),   P0[10],P0[11],P0[12],P0[13], pw1[0]=PKW(P0,8), pw1[1]=PKW(P0,10), pw1); \
    VRD(5); SBAR(); GAPA(C1=__builtin_amdgcn_mfma_f32_32x32x16_bf16(kf[3],qr[1],C1,0,0,0),   P0[14],P0[15],P1[0],P1[1],   pw1[2]=PKW(P0,12),pw1[3]=PKW(P0,14), pw1); \
    VRD(2); SBAR(); GAPA(C0=__builtin_amdgcn_mfma_f32_32x32x16_bf16(kf[4],qr[2],C0,0,0,0),   P1[2],P1[3],P1[4],P1[5],     pw2[0]=PKW(P1,0), pw2[1]=PKW(P1,2), pw2); \
    VRD(6); SBAR(); GAPA(C1=__builtin_amdgcn_mfma_f32_32x32x16_bf16(kf[5],qr[2],C1,0,0,0),   P1[6],P1[7],P1[8],P1[9],     pw2[2]=PKW(P1,4), pw2[3]=PKW(P1,6), pw2); \
    VRD(3); SBAR(); GAPA(C0=__builtin_amdgcn_mfma_f32_32x32x16_bf16(kf[6],qr[3],C0,0,0,0),   P1[10],P1[11],P1[12],P1[13], pw3[0]=PKW(P1,8), pw3[1]=PKW(P1,10), pw3); \
    VRD(7); SBAR(); GAPA(C1=__builtin_amdgcn_mfma_f32_32x32x16_bf16(kf[7],qr[3],C1,0,0,0),   P1[14],P1[15],0.f,0.f,       pw3[2]=PKW(P1,12),pw3[3]=PKW(P1,14), pw3); \
    l_reg+=sacc; \
    if(GK){DMA_K((t)+3,sl_cur);} if(GV){DMA_V((t)+1,sl_next);} \
    CMASK(C0,C1,t); \
    { float a=MX3(C0[0],C0[1],C1[0]),b=MX3(C0[2],C0[3],C1[1]); a=MX3(a,C1[2],C1[3]); \
      _Pragma("unroll") for(int r=4;r<16;r+=4){a=MX3(a,C0[r],C0[r+1]);b=MX3(b,C0[r+2],C0[r+3]);a=MX3(a,C1[r],C1[r+1]);b=MX3(b,C1[r+2],C1[r+3]);} \
      float rm=__builtin_fmaxf(a,b); { auto rr=__builtin_amdgcn_permlane32_swap(__float_as_uint(rm),__float_as_uint(rm),false,false); rm=__builtin_fmaxf(__uint_as_float(rr[0]),__uint_as_float(rr[1])); } \
      resc=false; \
      if(__builtin_expect(__any(rm>(float)THRL),0)){ const float dl=__builtin_fmaxf(rm,0.f); mhat+=dl; \
        _Pragma("unroll") for(int r=0;r<16;++r){C0[r]-=dl;C1[r]-=dl;} \
        _Pragma("unroll") for(int r=0;r<16;++r)negm[r]=-mhat; asm volatile("":"+v"(negm)); \
        const float f=__builtin_amdgcn_exp2f(-dl); l_reg*=f; if(hi==0)wsf[r32]=f; resc=true; } } \
    SBAR(); \
    GAPB(o[0]=__builtin_amdgcn_mfma_f32_32x32x16_bf16(PAF(0),VFR(0),o[0],0,0,0), C0,0); \
    GAPB(o[1]=__builtin_amdgcn_mfma_f32_32x32x16_bf16(PAF(0),VFR(4),o[1],0,0,0), C0,4); \
    KRD(GL,0); GAPB(o[0]=__builtin_amdgcn_mfma_f32_32x32x16_bf16(PAF(1),VFR(1),o[0],0,0,0), C0,8); \
    KRD(GL,1); GAPB(o[1]=__builtin_amdgcn_mfma_f32_32x32x16_bf16(PAF(1),VFR(5),o[1],0,0,0), C0,12); \
    KRD(GL,2); GAPB(o[0]=__builtin_amdgcn_mfma_f32_32x32x16_bf16(PAF(2),VFR(2),o[0],0,0,0), C1,0); \
    KRD(GL,3); GAPB(o[1]=__builtin_amdgcn_mfma_f32_32x32x16_bf16(PAF(2),VFR(6),o[1],0,0,0), C1,4); \
    GAPB(o[0]=__builtin_amdgcn_mfma_f32_32x32x16_bf16(PAF(3),VFR(3),o[0],0,0,0), C1,8); \
    GAPB(o[1]=__builtin_amdgcn_mfma_f32_32x32x16_bf16(PAF(3),VFR(7),o[1],0,0,0), C1,12); \
    }while(0)
  int t=1;
  #undef CMASK
  #define CMASK(P0,P1,t) do{}while(0)
  for(;t+5<NT;t+=2){
    STEP(pB0,pB1,pA0,pA1,t,true,true,true);     WAIT_BAR(2); RESC(); ROT();
    STEP(pA0,pA1,pB0,pB1,t+1,true,true,true);   WAIT_BAR(2); RESC(); ROT();
  }
  #undef CMASK
  #define CMASK(P0,P1,t) do{int jb_=(t)-(NT-4); if(jb_>=0)cmask(P0,P1,jb_,qrel,hi);}while(0)
  #define ENDW(tt) do{ if((tt)+3<NT){WAIT_BAR(2);} else if((tt)+2<NT){WAIT_BAR(1);} else {WAIT_BAR(0);} }while(0)
  for(;t+1<NT;t+=2){
    STEP(pB0,pB1,pA0,pA1,t,(t+3<NT),(t+1<NT),(t+1<NT));       ENDW(t);   RESC(); ROT();
    STEP(pA0,pA1,pB0,pB1,t+1,(t+4<NT),(t+2<NT),(t+2<NT));     ENDW(t+1); RESC(); ROT();
  }
  STEP(pB0,pB1,pA0,pA1,NT-1,false,false,false); RESC();
  { float sacc=pB0[0]+pB0[1]; _Pragma("unroll") for(int r=2;r<16;++r)sacc+=pB0[r]; _Pragma("unroll") for(int r=0;r<16;++r)sacc+=pB1[r]; l_reg+=sacc;
    pw0=(u32x4){PKW(pB0,0),PKW(pB0,2),PKW(pB0,4),PKW(pB0,6)};pw1=(u32x4){PKW(pB0,8),PKW(pB0,10),PKW(pB0,12),PKW(pB0,14)};pw2=(u32x4){PKW(pB1,0),PKW(pB1,2),PKW(pB1,4),PKW(pB1,6)};pw3=(u32x4){PKW(pB1,8),PKW(pB1,10),PKW(pB1,12),PKW(pB1,14)};
    SBAR(); pv(o,vb0+sl_cur,PAF(0),PAF(1),PAF(2),PAF(3)); }
  #undef PKW
  #undef PAF
  #undef VFR
  #undef PIN
  #undef MX3
  #undef GAPA
  #undef GAPB
  #undef EX
  #undef VRD
  #undef KRD
  #undef STEP
  #undef ENDW
  {auto rr=__builtin_amdgcn_permlane32_swap(__float_as_uint(l_reg),__float_as_uint(l_reg),false,false);l_reg=__uint_as_float(rr[0])+__uint_as_float(rr[1]);}
  if(hi==0)wsf[32+r32]=l_reg;asm volatile("s_waitcnt lgkmcnt(0)":::"memory");
  float rli[16];
  #pragma unroll
  for(int r=0;r<16;++r)rli[r]=__builtin_amdgcn_rcpf(wsf[32+crow(r,hi)]);
  bf16*Ow=O+(rowbase+q0+wid*QBLK)*DM+vc;
  { bf16*stg=(bf16*)(shm+LDS_OST)+wid*2048;
    #pragma unroll
    for(int r=0;r<16;++r){const int orow=crow(r,hi);
      #pragma unroll
      for(int d0=0;d0<2;++d0)stg[orow*64+d0*32+r32]=__float2bfloat16(o[d0][r]*rli[r]);}
    asm volatile("s_waitcnt lgkmcnt(0)":::"memory");
    #pragma unroll
    for(int i=0;i<4;++i){const int row=i*8+(lane>>3),ch=lane&7; const u32x4 v=*(const u32x4*)(stg+row*64+ch*8); ATTN_STORE16(Ow+(long)row*DM+ch*8,v);} }
  asm volatile("s_waitcnt lgkmcnt(0)\n\ts_barrier":::"memory");
  #undef DMA_K
  #undef DMA_V
  #undef CMASK
  #undef START
  #undef RESC
  #undef ROT
}
constexpr int ATTN_LDS_BYTES=LDS_BYTES;
#undef SBAR
#undef WAIT_BAR
}

#define LAS __attribute__((address_space(3)))
typedef unsigned short bf16;
typedef unsigned v4u __attribute__((ext_vector_type(4)));
typedef unsigned v2u __attribute__((ext_vector_type(2)));
typedef float f32x4 __attribute__((ext_vector_type(4)));

__device__ __forceinline__ float lane_xor(float v, int lane, int o) { return __int_as_float(__builtin_amdgcn_ds_bpermute((lane ^ o) << 2, __float_as_int(v))); }
__device__ __forceinline__ float wave_sum(float v, int lane) {
#pragma unroll
    for (int o = 1; o < 64; o <<= 1) v += lane_xor(v, lane, o);
    return v;
}
__device__ __forceinline__ unsigned f2bf(float f) { unsigned u = __builtin_bit_cast(unsigned, f); return (u + 0x7fffu + ((u >> 16) & 1u)) >> 16; }
__device__ __forceinline__ unsigned pk2(float lo, float hi) { return f2bf(lo) | (f2bf(hi) << 16); }
__device__ __forceinline__ float bflo(unsigned w) { return __uint_as_float(w << 16); }
__device__ __forceinline__ float bfhi(unsigned w) { return __uint_as_float(w & 0xffff0000u); }
__device__ __forceinline__ void sincos_d(double ang, float& s, float& c) { double t = ang * 0.15915494309189535; t -= rint(t); const float f = (float)t; s = __builtin_amdgcn_sinf(f); c = __builtin_amdgcn_cosf(f); }

__device__ __forceinline__ void p0_transpose_item(const float* W, int K, int N, bf16* WT, int srccol0, int dstrow0, int k0, LAS float* scr, int lane) {
#pragma unroll
    for (int i = 0; i < 32; ++i) { const int kk = 2 * i + (lane >> 5); scr[kk * 33 + (lane & 31)] = W[(size_t)(k0 + kk) * N + srccol0 + (lane & 31)]; }
    asm volatile("s_waitcnt lgkmcnt(0)" ::: "memory");
    const int c = lane & 7;
#pragma unroll
    for (int j = 0; j < 4; ++j) { const int n = (lane >> 3) + 8 * j; const LAS float* s = scr + (8 * c) * 33 + n;
        v4u o; o.x = pk2(s[0 * 33], s[1 * 33]); o.y = pk2(s[2 * 33], s[3 * 33]); o.z = pk2(s[4 * 33], s[5 * 33]); o.w = pk2(s[6 * 33], s[7 * 33]);
        *(GASP v4u*)(WT + (size_t)(dstrow0 + n) * K + k0 + 8 * c) = o; }
    asm volatile("s_waitcnt lgkmcnt(0)" ::: "memory");
}
__device__ __forceinline__ int win_srccol(int r0) { const int pn = r0 >> 8, seg = pn >> 2; if (seg == 2 || seg == 3) { const int s = r0 & 255; return (pn << 8) + 64 * ((s & 127) >> 5) + 32 * (s >> 7); } return r0; }
__device__ __forceinline__ int wglu_srccol(int r0) { const int pn = r0 >> 8, s = r0 & 255; return (s >> 7) * 1024 + pn * 128 + (s & 127); }

#define XB_TMO      128
#define XB_XCNT(j)  (256  + 64 * (j))
#define XB_XSUB(j)  (1280 + 64 * (j))
#define XB_XGEN(j)  (2304 + 64 * (j))
#define XB_TOP      3328
#define XB_TOPGEN   3392
#define XCD_BAR_WORDS 3456
#define XB_SPIN_CAP (1u << 22)

__device__ __forceinline__ unsigned xb_ld(unsigned* p)              { return __hip_atomic_load(p, __ATOMIC_RELAXED, __HIP_MEMORY_SCOPE_AGENT); }
__device__ __forceinline__ unsigned xb_add(unsigned* p, unsigned v) { return __hip_atomic_fetch_add(p, v, __ATOMIC_RELAXED, __HIP_MEMORY_SCOPE_AGENT); }
__device__ __forceinline__ unsigned xb_xcc_id() { return (unsigned)__builtin_amdgcn_s_getreg((3 << 11) | 20) & 0xFu; }
#define XB_SPIN(cond, bar) do { unsigned _sp = 0; while (cond) { __builtin_amdgcn_s_sleep(1); \
    if ((++_sp & 255u) == 0u) { if (xb_ld(&(bar)[XB_TMO])) break; if (_sp > XB_SPIN_CAP) { atomicAdd(&(bar)[XB_TMO], 1u); break; } } } } while (0)

struct XcdBarrier {
    unsigned* bar; unsigned x;
    volatile LAS unsigned* st;
};

__device__ __forceinline__ XcdBarrier xcd_barrier_post(unsigned* bar, volatile LAS unsigned* st) {
    XcdBarrier b; b.bar = bar; b.x = xb_xcc_id(); b.st = st;
    if (threadIdx.x == 0) (void)xb_add(&bar[XB_XCNT(b.x)], 1u);
    return b;
}
__device__ __forceinline__ void xcd_barrier_complete(unsigned* bar, unsigned x, unsigned& nloc, unsigned& nx) {
    const unsigned G = gridDim.x * gridDim.y * gridDim.z;
    unsigned sum, cnt, mine, sp = 0u;
    for (;;) {
        sum = 0u; cnt = 0u; mine = 0u;
#pragma unroll
        for (unsigned j = 0; j < 16; ++j) { const unsigned c = xb_ld(&bar[XB_XCNT(j)]); sum += c; cnt += (c > 0u) ? 1u : 0u; mine = (j == x) ? c : mine; }
        if (sum == G) break;
        __builtin_amdgcn_s_sleep(1);
        if ((++sp & 255u) == 0u) { if (xb_ld(&bar[XB_TMO])) break; if (sp > XB_SPIN_CAP) { atomicAdd(&bar[XB_TMO], 1u); break; } }
    }
    nloc = mine > 0u ? mine : 1u; nx = cnt > 0u ? cnt : 1u;
}

__device__ __forceinline__ void xcd_barrier(const XcdBarrier& b) {
    asm volatile("s_waitcnt vmcnt(0)" ::: "memory");
    __syncthreads();
    if (threadIdx.x == 0) {
        unsigned* bar = b.bar;
        __builtin_amdgcn_s_waitcnt(0);
        unsigned nloc = b.st[0], nx = b.st[1];
        if (nloc == 0u) { xcd_barrier_complete(bar, b.x, nloc, nx); b.st[0] = nloc; b.st[1] = nx; }
        const unsigned old = xb_add(&bar[XB_XSUB(b.x)], 1u);
        const unsigned gen = old / nloc;
        if (old + 1u == (gen + 1u) * nloc) {
            __builtin_amdgcn_fence(__ATOMIC_RELEASE, "agent");
            asm volatile("s_waitcnt vmcnt(0)" ::: "memory");
            const unsigned og = xb_add(&bar[XB_TOP], 1u);
            const unsigned tg = og / nx;
            if (og + 1u == (tg + 1u) * nx) xb_add(&bar[XB_TOPGEN], 1u);
            else XB_SPIN(xb_ld(&bar[XB_TOPGEN]) == tg, bar);
            __builtin_amdgcn_fence(__ATOMIC_ACQUIRE, "agent");
            xb_add(&bar[XB_XGEN(b.x)], 1u);
            asm volatile("s_waitcnt vmcnt(0)" ::: "memory");
        } else {
            XB_SPIN(xb_ld(&bar[XB_XGEN(b.x)]) == gen, bar);
            __builtin_amdgcn_fence(__ATOMIC_ACQUIRE, "agent");
            asm volatile("s_waitcnt vmcnt(0)" ::: "memory");
        }
    }
    __syncthreads();
}

struct Args { const void* in[24]; float* out; unsigned char* ws; };
constexpr int XB_ST_OFF = 131072 + 512;
constexpr size_t WS_CTL = 896 * 1024, CTL_BYTES = 16384;
constexpr int PTR_STASH = 131072;
__device__ __forceinline__ const void* ldp(LAS unsigned char* L, int i) { int z = 0; asm volatile("" : "+v"(z)); const unsigned long long v = *(volatile LAS unsigned long long*)(L + PTR_STASH + 8 * i + z);
    const unsigned lo = __builtin_amdgcn_readfirstlane((unsigned)v), hi = __builtin_amdgcn_readfirstlane((unsigned)(v >> 32)); return (const void*)(((unsigned long long)hi << 32) | lo); }

__global__ void __launch_bounds__(NWAVES * 64, 2) fwd_kernel(Args args) {
    extern __shared__ __attribute__((aligned(16))) unsigned char lds[];
    cg::grid_group grid = cg::this_grid();
    LAS unsigned char* L = (LAS unsigned char*)lds;
    const int tid = threadIdx.x, lane = tid & 63, wave = __builtin_amdgcn_readfirstlane(tid >> 6);
    const int G = gridDim.x, bx = blockIdx.x, wave_s = wave;
    if (tid == 0) { LAS unsigned long long* P = (LAS unsigned long long*)(L + PTR_STASH);
#pragma unroll
        for (int i = 0; i < 24; ++i) P[i] = (unsigned long long)args.in[i];
        P[24] = (unsigned long long)args.out; P[25] = (unsigned long long)args.ws; }
    if (tid < 2) ((LAS unsigned*)(L + XB_ST_OFF))[tid] = 0u;
    __syncthreads();
    if (bx == 0) { unsigned* ctl0 = (unsigned*)(args.ws + WS_CTL); for (int i = tid; i < (int)(CTL_BYTES / 4); i += 512) ctl0[i] = 0u; }
#define GRID_BAR() do { XcdBarrier xb_; xb_.bar = (unsigned*)((unsigned char*)ldp(L, 25) + WS_CTL); xb_.x = xb_xcc_id(); xb_.st = (volatile LAS unsigned*)(L + XB_ST_OFF); xcd_barrier(xb_); } while (0)
    const int gw = bx * NWAVES + wave, NGW = G * NWAVES;
    const int gt = bx * 512 + tid, GT = G * 512;
    unsigned char* ws = args.ws;
    const float* x_in = (const float*)args.in[0];
    const float* c_in = (const float*)args.in[1];
    const int* pos_in = (const int*)args.in[2];
    const float* norm_g = (const float*)args.in[3];
    const float* w_ada = (const float*)args.in[4];
    const float* b_ada = (const float*)args.in[5];
    const float* w_in = (const float*)args.in[6];
    const float* w_out = (const float*)args.in[7];
    const float* a_re = (const float*)args.in[8];
    const float* a_im = (const float*)args.in[9];
    const float* b_re = (const float*)args.in[10];
    const float* b_im = (const float*)args.in[11];
    const float* c_re = (const float*)args.in[12];
    const float* c_im = (const float*)args.in[13];
    const float* ssm_d = (const float*)args.in[14];
    const float* log_step = (const float*)args.in[15];
    const float* w_glu = (const float*)args.in[16];
    const float* b_glu = (const float*)args.in[17];
    const float* lam_q1 = (const float*)args.in[18];
    const float* lam_k1 = (const float*)args.in[19];
    const float* lam_q2 = (const float*)args.in[20];
    const float* lam_k2 = (const float*)args.in[21];
    const float* sub_g = (const float*)args.in[22];
    const float* final_g = (const float*)args.in[23];
    float* MOD = (float*)(ws + WS_MOD);
    float* ROPEC = (float*)(ws + WS_ROPEC); float* ROPES = (float*)(ws + WS_ROPES);

    {
        LAS float* cact = (LAS float*)L; LAS float* part = cact + 8 * 2048;
        for (int i = tid; i < 8 * 2048; i += 512) { const float v = c_in[i]; cact[i] = v / (1.f + expf(-v)); }
        __syncthreads();
        for (int task = bx; task < DEPTH * 96; task += G) {
            const int l = task / 96, cb = task % 96;
            const float* w = w_ada + ((size_t)l * 2048 + wave * 256) * 6144 + cb * 64 + lane;
            float a0 = 0.f, a1 = 0.f, a2 = 0.f, a3 = 0.f, a4 = 0.f, a5 = 0.f, a6 = 0.f, a7 = 0.f;
            const LAS float* cw = cact + wave * 256;
#pragma unroll 32
            for (int kk = 0; kk < 256; ++kk) { const float wv = w[(size_t)kk * 6144];
                a0 += cw[kk] * wv; a1 += cw[2048 + kk] * wv; a2 += cw[4096 + kk] * wv; a3 += cw[6144 + kk] * wv;
                a4 += cw[8192 + kk] * wv; a5 += cw[10240 + kk] * wv; a6 += cw[12288 + kk] * wv; a7 += cw[14336 + kk] * wv; }
            LAS float* pw = part + wave * 512 + lane;
            pw[0] = a0; pw[64] = a1; pw[128] = a2; pw[192] = a3; pw[256] = a4; pw[320] = a5; pw[384] = a6; pw[448] = a7;
            __syncthreads();
            { const int b = tid >> 6; float s = b_ada[(size_t)l * 6144 + cb * 64 + lane];
#pragma unroll
              for (int w8 = 0; w8 < 8; ++w8) s += part[w8 * 512 + b * 64 + lane];
              MOD[((size_t)l * 8 + b) * 6144 + cb * 64 + lane] = s; }
            __syncthreads();
        }
    }
    {
        LAS float* ap = (LAS float*)L;
        LAS float* bb = ap + 17 * 64 * 2;
        LAS float* cc = bb + 64 * 16 * 2;
        LAS float* kt = cc + 16 * 64 * 2;
        for (int it = bx; it < DEPTH * 64; it += G) {
            const int l = it >> 6, g = it & 63, lg = it;
            const float step = expf(log_step[lg]);
            for (int idx = tid; idx < 17 * 64; idx += 512) { const int j = idx >> 6, n = idx & 63;
                const float re = a_re[lg * 64 + n], im = a_im[lg * 64 + n];
                const float mag = expf(re * step * (float)j); float s, c; sincos_d((double)im * (double)step * (double)j, s, c);
                ap[idx * 2] = mag * c; ap[idx * 2 + 1] = mag * s; }
            for (int idx = tid; idx < 64 * 16; idx += 512) { const int n = idx >> 4;
                const float re = a_re[lg * 64 + n], im = a_im[lg * 64 + n];
                const float xr = re * step; const float ex = expf(xr), em1 = expm1f(xr);
                float sy, cy, sh, chh; sincos_d((double)im * (double)step, sy, cy); sincos_d(0.5 * (double)im * (double)step, sh, chh);
                const float nr = em1 * cy - 2.f * sh * sh, ni = ex * sy;
                const float den = re * re + im * im, cr = (nr * re + ni * im) / den, ci = (ni * re - nr * im) / den;
                const float br = b_re[(size_t)lg * 1024 + idx], bi = b_im[(size_t)lg * 1024 + idx];
                bb[idx * 2] = cr * br - ci * bi; bb[idx * 2 + 1] = cr * bi + ci * br; }
            for (int idx = tid; idx < 1024; idx += 512) { cc[idx * 2] = c_re[(size_t)lg * 1024 + idx]; cc[idx * 2 + 1] = c_im[(size_t)lg * 1024 + idx]; }
            __syncthreads();
            for (int idx = tid; idx < 4096; idx += 512) { const int j = idx >> 8, p = (idx >> 4) & 15, q = idx & 15; float sum = 0.f;
                for (int n = 0; n < 64; ++n) { const float cr = cc[(p * 64 + n) * 2], ci = cc[(p * 64 + n) * 2 + 1], ar = ap[(j * 64 + n) * 2], ai = ap[(j * 64 + n) * 2 + 1];
                    const float tr = cr * ar - ci * ai, ti = cr * ai + ci * ar; sum += tr * bb[(n * 16 + q) * 2] - ti * bb[(n * 16 + q) * 2 + 1]; }
                if (j == 0 && p == q) sum += ssm_d[lg * 16 + p];
                kt[idx] = sum; }
            __syncthreads();
            bf16* W1 = (bf16*)(ws + WS_S5W + (size_t)l * S5W_LAYER) + (size_t)g * 128 * 256;
            bf16* W2 = (bf16*)(ws + WS_S5W + (size_t)l * S5W_LAYER + S5W2_OFF) + (size_t)g * 256 * 384;
            for (int i2 = tid; i2 < 256 * 192; i2 += 512) { const int row = i2 / 192, c0 = (i2 % 192) * 2, t = row >> 4, p = row & 15; float v[2];
#pragma unroll
                for (int e = 0; e < 2; ++e) { const int col = c0 + e;
                    if (col < 256) { const int tau = col >> 4, q = col & 15; v[e] = (tau <= t) ? kt[((t - tau) << 8) + (p << 4) + q] : 0.f; }
                    else { const int n = (col - 256) & 63; const float cr = cc[(p * 64 + n) * 2], ci = cc[(p * 64 + n) * 2 + 1], ar = ap[((t + 1) * 64 + n) * 2], ai = ap[((t + 1) * 64 + n) * 2 + 1];
                        v[e] = (col < 320) ? (cr * ar - ci * ai) : -(cr * ai + ci * ar); } }
                *(unsigned*)(W2 + (size_t)row * 384 + c0) = pk2(v[0], v[1]); }
            for (int i2 = tid; i2 < 128 * 128; i2 += 512) { const int row = i2 >> 7, c0 = (i2 & 127) * 2, n = row & 63; float v[2];
#pragma unroll
                for (int e = 0; e < 2; ++e) { const int col = c0 + e, tau = col >> 4, p = col & 15;
                    const float ar = ap[((15 - tau) * 64 + n) * 2], ai = ap[((15 - tau) * 64 + n) * 2 + 1], br = bb[(n * 16 + p) * 2], bi = bb[(n * 16 + p) * 2 + 1];
                    v[e] = (row < 64) ? (ar * br - ai * bi) : (ar * bi + ai * br); }
                *(unsigned*)(W1 + (size_t)row * 256 + c0) = pk2(v[0], v[1]); }
            __syncthreads();
        }
    }
    {
        for (int i = gt; i < NTOK * 32; i += GT) { const int j = i & 31; const int p = pos_in[i >> 5];
            const float inv = (float)exp2(-(double)j * (13.287712379549449 / 32.0));
            const float ang = (float)p * inv; float s, c; sincos_d((double)ang, s, c);
            ROPEC[i] = c; ROPES[i] = s; }
    }
    {
        LAS float* scr = (LAS float*)(L + wave * 16384);
        constexpr int I_IN = 32 * 192, I_OUT = 32 * 64, I_GLU = 16 * 64, I_L = I_IN + I_OUT + I_GLU;
        for (int it = gw; it < DEPTH * I_L; it += NGW) {
            const int l = it / I_L; int r = it % I_L;
            if (r < I_IN) { const int kb = r / 192, sb = r % 192; p0_transpose_item(w_in + (size_t)l * 2048 * 6144, 2048, 6144, (bf16*)(ws + WS_WIN) + (size_t)l * 6144 * 2048, win_srccol(sb * 32), sb * 32, kb * 64, scr, lane); continue; }
            r -= I_IN;
            if (r < I_OUT) { const int kb = r / 64, sb = r % 64; p0_transpose_item(w_out + (size_t)l * 2048 * 2048, 2048, 2048, (bf16*)(ws + WS_WOUT) + (size_t)l * 2048 * 2048, sb * 32, sb * 32, kb * 64, scr, lane); continue; }
            r -= I_OUT;
            { const int kb = r / 64, sb = r % 64; p0_transpose_item(w_glu + (size_t)l * 1024 * 2048, 1024, 2048, (bf16*)(ws + WS_WGLU) + (size_t)l * 2048 * 1024, wglu_srccol(sb * 32), sb * 32, kb * 64, scr, lane); }
        }
    }
    grid.sync();
    (void)xcd_barrier_post((unsigned*)((unsigned char*)ldp(L, 25) + WS_CTL), (volatile LAS unsigned*)(L + XB_ST_OFF));

#define PHASE_BEGIN() int zp_ = 0; asm volatile("" : "+v"(zp_)); int wv_ = wave_s, bxp_ = bx; asm volatile("" : "+s"(wv_), "+s"(bxp_)); const int lane = (int)__builtin_amdgcn_mbcnt_hi(~0u, __builtin_amdgcn_mbcnt_lo(~0u, (unsigned)zp_)), wave = wv_; const int tidp = wv_ * 64 + lane; const int gw = bxp_ * NWAVES + wave; unsigned char* ws = (unsigned char*)ldp(L, 25); (void)lane; (void)gw
#define WSP(T, off) ((T*)(ws + (off)))
#define LANE_ID(var) int var; { int z_ = 0; asm volatile("" : "+v"(z_)); var = (int)__builtin_amdgcn_mbcnt_hi(~0u, __builtin_amdgcn_mbcnt_lo(~0u, (unsigned)z_)); }
    {
        PHASE_BEGIN();
        const float* xin = (const float*)ldp(L, 0); const float* gl = (const float*)ldp(L, 3); const float* modl = WSP(const float, WS_MOD);
        bf16* XG = WSP(bf16, WS_H); float* ss0 = WSP(float, WS_SS);
        for (int m0 = gw * 2; m0 < NTOK; m0 += NGW * 2) {
            const int b = m0 >> 12;
            const GASP f32x4* xr = (const GASP f32x4*)(xin + (size_t)m0 * 2048) + lane;
            f32x4 v[2][8]; float s0 = 0.f, s1 = 0.f;
#pragma unroll
            for (int j = 0; j < 8; ++j) { v[0][j] = xr[64 * j]; v[1][j] = xr[512 + 64 * j]; }
#pragma unroll
            for (int j = 0; j < 8; ++j) { s0 += (v[0][j].x * v[0][j].x + v[0][j].y * v[0][j].y) + (v[0][j].z * v[0][j].z + v[0][j].w * v[0][j].w); s1 += (v[1][j].x * v[1][j].x + v[1][j].y * v[1][j].y) + (v[1][j].z * v[1][j].z + v[1][j].w * v[1][j].w); }
            s0 = wave_sum(s0, lane); s1 = wave_sum(s1, lane);
            if (lane == 0) { ((GASP float*)ss0)[m0] = s0; ((GASP float*)ss0)[m0 + 1] = s1; }
#pragma unroll
            for (int j = 0; j < 8; ++j) { const int k = 256 * j + 4 * lane;
                const f32x4 gm = *(const GASP f32x4*)(gl + k) * (*(const GASP f32x4*)(modl + (size_t)b * 6144 + 2048 + k) + 1.f);
                const f32x4 o0 = v[0][j] * gm, o1 = v[1][j] * gm;
                v2u w0, w1; w0.x = pk2(o0.x, o0.y); w0.y = pk2(o0.z, o0.w); w1.x = pk2(o1.x, o1.y); w1.y = pk2(o1.z, o1.w);
                *(GASP v2u*)(XG + (size_t)m0 * 2048 + k) = w0; *(GASP v2u*)(XG + (size_t)(m0 + 1) * 2048 + k) = w1; }
        }
        LAS float* sh = (LAS float*)L;
        for (int ll = 0; ll < DEPTH; ++ll) {
            __syncthreads();
            for (int i = tidp; i < 8 * 512; i += 512) { const int bb = i >> 9, k4 = (i & 511) * 4; *(LAS f32x4*)(sh + bb * 2048 + k4) = *(const GASP f32x4*)(modl + ((size_t)ll * 8 + bb) * 6144 + k4); }
            __syncthreads();
            const bf16* WT = WSP(const bf16, WS_WIN) + (size_t)ll * 6144 * 2048; float* bias = WSP(float, WS_BIAS) + (size_t)ll * 8 * 6144;
            for (int r = gw; r < INW; r += NGW) {
                float a8[8];
#pragma unroll
                for (int bb = 0; bb < 8; ++bb) a8[bb] = 0.f;
#pragma unroll 1
                for (int j = 0; j < 4; ++j) { const int k = j * 512 + lane * 8; const v4u wv = *(const GASP v4u*)(WT + (size_t)r * 2048 + k);
                    const float w0 = bflo(wv.x), w1 = bfhi(wv.x), w2 = bflo(wv.y), w3 = bfhi(wv.y), w4 = bflo(wv.z), w5 = bfhi(wv.z), w6 = bflo(wv.w), w7 = bfhi(wv.w);
#pragma unroll
                    for (int bb = 0; bb < 8; ++bb) { const f32x4 sa = *(const LAS f32x4*)(sh + bb * 2048 + k), sb = *(const LAS f32x4*)(sh + bb * 2048 + k + 4);
                        a8[bb] += (sa.x * w0 + sa.y * w1) + (sa.z * w2 + sa.w * w3) + (sb.x * w4 + sb.y * w5) + (sb.z * w6 + sb.w * w7); } }
#pragma unroll
                for (int bb = 0; bb < 8; ++bb) { const float s = wave_sum(a8[bb], lane); if (lane == 0) ((GASP float*)bias)[(size_t)bb * 6144 + r] = s; }
            }
        }
    }
    GRID_BAR();
    for (int l = 0; l < DEPTH; ++l) {
        {
            PHASE_BEGIN();
            pg8::Gemm g{WSP(const bf16, WS_H), WSP(const bf16, WS_WIN) + (size_t)l * 6144 * 2048, NTOK, INW, 2048, 2048, 2048, 1 << 30, 0};
            pg8::StaticOrder S; S.init(NTOK, INW, G, bx);
            pg8::EpiInProj Ep{ws, l};
            pg8::gemm_phase<pg8::EpiInProj, pg8::StaticOrder, true, true>(L, g, S, Ep, tidp);
        }
        GRID_BAR();
        {
            PHASE_BEGIN();
            pg8::Gemm g{WSP(const bf16, WS_A2), WSP(const bf16, WS_S5W + (size_t)l * S5W_LAYER), 64 * 2048, 256, 256, pg8::A2_LD, 256, 8, 128};
            pg8::StaticOrder S; S.init(64 * 2048, 256, G, bx);
            pg8::EpiS5P1 Ep{ws};
            pg8::gemm_phase<pg8::EpiS5P1, pg8::StaticOrder, true, true>(L, g, S, Ep, tidp);
        }
        asm volatile("s_waitcnt vmcnt(0) lgkmcnt(0)" ::: "memory"); __syncthreads();
        {
            PHASE_BEGIN();
            LAS float* tot = (LAS float*)L;
            { float* ssz = WSP(float, WS_SS) + ((l + 1) & 1) * 32768; for (int i = bx * 512 + tidp; i < 32768; i += G * 512) ((GASP float*)ssz)[i] = 0.f; }
            const float* log_step = (const float*)ldp(L, 15); const float* a_re = (const float*)ldp(L, 8); const float* a_im = (const float*)ldp(L, 9);
            const float* E = WSP(const float, WS_H); bf16* A2 = WSP(bf16, WS_A2);
            pg8::StaticOrder SO; SO.init(64 * 2048, 256, G, bx);
            pg8::Unit su;
            for (int ui = 0; SO.next(ui, su); ++ui) {
                const int b = su.pm & 7, g = su.pm >> 3, n = lane, seg = wave, lg = l * 64 + g;
                const float step = expf(log_step[lg]); const float re = a_re[lg * 64 + n], im = a_im[lg * 64 + n];
                float aLr, aLi; { const float mag = expf(re * step * 16.f); float s, c; sincos_d((double)im * (double)step * 16.0, s, c); aLr = mag * c; aLi = mag * s; }
                const GASP float* Ep = (const GASP float*)(E + ((size_t)(g * 2048 + b * 256 + seg * 32)) * 128 + n);
                float hr[32], hi[32]; float sr = 0.f, si = 0.f;
                float ev[32], eu[32];
#pragma unroll
                for (int j = 0; j < 32; ++j) { ev[j] = Ep[(size_t)j * 128]; eu[j] = Ep[(size_t)j * 128 + 64]; }
                asm volatile("" ::: "memory");
#pragma unroll
                for (int j = 0; j < 32; ++j) { const float er = ev[j], ei = eu[j];
                    const float tr = aLr * sr - aLi * si + er, ti = aLr * si + aLi * sr + ei; sr = tr; si = ti; hr[j] = sr; hi[j] = si; }
                tot[(seg * 64 + n) * 2] = sr; tot[(seg * 64 + n) * 2 + 1] = si;
                float pr = aLr, pi = aLi;
#pragma unroll
                for (int q = 0; q < 5; ++q) { const float tr = pr * pr - pi * pi, ti = 2.f * pr * pi; pr = tr; pi = ti; }
                __syncthreads();
                float cr = 0.f, ci = 0.f;
                for (int s2 = 0; s2 < seg; ++s2) { const float tr = pr * cr - pi * ci + tot[(s2 * 64 + n) * 2], ti = pr * ci + pi * cr + tot[(s2 * 64 + n) * 2 + 1]; cr = tr; ci = ti; }
                GASP bf16* Ap = (GASP bf16*)(A2 + ((size_t)(g * 2048 + b * 256 + seg * 32)) * pg8::A2_LD + 256 + n);
#pragma unroll
                for (int j = 0; j < 32; ++j) { const float vr = cr + (j ? hr[j - 1] : 0.f), vi = ci + (j ? hi[j - 1] : 0.f);
                    Ap[(size_t)j * pg8::A2_LD] = (bf16)f2bf(vr); Ap[(size_t)j * pg8::A2_LD + 64] = (bf16)f2bf(vi);
                    const float tr = aLr * cr - aLi * ci, ti = aLr * ci + aLi * cr; cr = tr; ci = ti; }
                __syncthreads();
            }
        }
        asm volatile("s_waitcnt vmcnt(0) lgkmcnt(0)" ::: "memory"); __syncthreads();
        {
            PHASE_BEGIN();
            pg8::Gemm g{WSP(const bf16, WS_A2), WSP(const bf16, WS_S5W + (size_t)l * S5W_LAYER + S5W2_OFF), 64 * 2048, 256, 384, pg8::A2_LD, 384, 8, 256};
            pg8::StaticOrder S; S.init(64 * 2048, 256, G, bx);
            pg8::EpiS5P2 Ep{ws};
            pg8::gemm_phase<pg8::EpiS5P2, pg8::StaticOrder, true, true>(L, g, S, Ep, tidp);
        }
        GRID_BAR();
        {
            PHASE_BEGIN();
            pg8::Gemm g{WSP(const bf16, WS_E), WSP(const bf16, WS_WGLU) + (size_t)l * 2048 * 1024, NTOK, 2048, 1024, 1024, 1024, 1 << 30, 0};
            pg8::StaticOrder S; S.init(NTOK, 2048, G, bx);
            pg8::EpiGlu Ep{ws, (const float*)ldp(L, 17) + (size_t)l * 2048};
            pg8::gemm_phase<pg8::EpiGlu, pg8::StaticOrder, true, true>(L, g, S, Ep, tidp);
        }
        {
            PHASE_BEGIN();
            const int vcu = (G % 8 == 0) ? (bx % 8) * (G / 8) + bx / 8 : bx;
            for (int grp = vcu; grp < 256; grp += G) {
                const int b = grp >> 5, h = (grp >> 2) & 7, s4 = grp & 3;
                for (int cm = 0; cm < 4; ++cm) { const int mp = cm >> 1, vh = cm & 1;
                    for (int qi = 0; qi < 4; ++qi) {
                        const int qb = (qi == 0) ? 15 - s4 : (qi == 1) ? 8 + s4 : (qi == 2) ? 7 - s4 : s4;
                        int t2 = tidp; asm volatile("" : "+v"(t2));
                        unsigned char* w2 = ws; asm volatile("" : "+s"(w2));
                        attn_body::attn_unit<8>(b, (h * 2 + mp) * 64, h * 128 + vh * 64, qb, (const attn_body::bf16*)(w2 + WS_Q), (const attn_body::bf16*)(w2 + WS_K), (const attn_body::bf16*)(w2 + WS_V),
                                                (attn_body::bf16*)(w2 + WS_H) + (mp ? (size_t)NTOK * 1024 : 0), (char*)lds, t2); } }
                for (int qi = 0; qi < 4; ++qi) {
                    const int qb = (qi == 0) ? 15 - s4 : (qi == 1) ? 8 + s4 : (qi == 2) ? 7 - s4 : s4;
                    {
                        asm volatile("s_waitcnt vmcnt(0)" ::: "memory");
                        int ln = tidp & 63; asm volatile("" : "+v"(ln));
                        unsigned char* w2 = ws; asm volatile("" : "+s"(w2));
                        const float lambda_init = 0.8f - 0.6f * expf(-0.3f * (float)l);
                        const float* lq1 = (const float*)ldp(L, 18); const float* lk1 = (const float*)ldp(L, 19); const float* lq2 = (const float*)ldp(L, 20); const float* lk2 = (const float*)ldp(L, 21);
                        const float d1 = wave_sum(lq1[l * 64 + ln] * lk1[l * 64 + ln], ln), d2 = wave_sum(lq2[l * 64 + ln] * lk2[l * 64 + ln], ln);
                        const float lam = expf(d1) - expf(d2) + lambda_init;
                        const int c8 = (ln & 15) * 8, sub = ln >> 4;
                        const float* sg = (const float*)ldp(L, 22) + (size_t)l * 128 + c8;
                        const f32x4 sg0 = *(const GASP f32x4*)sg * (1.f - lambda_init), sg1 = *(const GASP f32x4*)(sg + 4) * (1.f - lambda_init);
                        const size_t r0 = (size_t)b * SEQ + qb * 256 + wave * 32 + sub;
                        const bf16* O1 = (const bf16*)(w2 + WS_H); const bf16* O2 = O1 + (size_t)NTOK * 1024; const bf16* ZA = (const bf16*)(w2 + WS_ZA); bf16* YCAT = (bf16*)(w2 + WS_A2);
                        v4u pp[8], qq[8], zz[8];
#pragma unroll
                        for (int it = 0; it < 8; ++it) { const size_t off = (r0 + it * 4) * 1024 + h * 128 + c8;
                            pp[it] = *(const GASP v4u*)(O1 + off); qq[it] = *(const GASP v4u*)(O2 + off);
                            zz[it] = *(const GASP v4u*)(ZA + off); }
#pragma unroll
                        for (int it = 0; it < 8; ++it) { const size_t row = r0 + it * 4; const v4u p = pp[it], q = qq[it], z = zz[it];
                            float d[8]; float ss = 0.f;
#pragma unroll
                            for (int e = 0; e < 4; ++e) { d[2 * e] = bflo(p[e]) - lam * bflo(q[e]); d[2 * e + 1] = bfhi(p[e]) - lam * bfhi(q[e]); ss += d[2 * e] * d[2 * e] + d[2 * e + 1] * d[2 * e + 1]; }
                            ss += lane_xor(ss, ln, 1); ss += lane_xor(ss, ln, 2); ss += lane_xor(ss, ln, 4); ss += lane_xor(ss, ln, 8);
                            const float r = 1.0f / sqrtf(ss * (1.f / 128.f) + 1e-6f);
                            v4u o;
                            o[0] = pk2(d[0] * r * sg0[0] * bflo(z[0]), d[1] * r * sg0[1] * bfhi(z[0])); o[1] = pk2(d[2] * r * sg0[2] * bflo(z[1]), d[3] * r * sg0[3] * bfhi(z[1]));
                            o[2] = pk2(d[4] * r * sg1[0] * bflo(z[2]), d[5] * r * sg1[1] * bfhi(z[2])); o[3] = pk2(d[6] * r * sg1[2] * bflo(z[3]), d[7] * r * sg1[3] * bfhi(z[3]));
                            *(GASP v4u*)(YCAT + row * 2048 + 1024 + h * 128 + c8) = o; }
                    }
                }
            }
        }
        GRID_BAR();
        {
            PHASE_BEGIN();
            pg8::Gemm g{WSP(const bf16, WS_A2), WSP(const bf16, WS_WOUT) + (size_t)l * 2048 * 2048, NTOK, 2048, 2048, 2048, 2048, 1 << 30, 0};
            pg8::StaticOrder S; S.init(NTOK, 2048, G, bx);
            pg8::EpiOut Ep{(l == 0) ? (const float*)ldp(L, 0) : (const float*)ldp(L, 24), (float*)ldp(L, 24), ws, (const float*)ldp(L, 3) + (size_t)(l < 3 ? l + 1 : 0) * 2048, l};
            pg8::gemm_phase<pg8::EpiOut, pg8::StaticOrder, true, true>(L, g, S, Ep, tidp);
        }
        GRID_BAR();
    }
    {
        PHASE_BEGIN();
        float* xres = (float*)ldp(L, 24); const float* final_g = (const float*)ldp(L, 23); (void)ws;
        for (int m = gw; m < NTOK; m += NGW) {
            GASP f32x4* xr = (GASP f32x4*)(xres + (size_t)m * 2048) + lane;
            f32x4 v[8]; float s = 0.f;
#pragma unroll
            for (int j = 0; j < 8; ++j) { v[j] = xr[64 * j]; s += (v[j].x * v[j].x + v[j].y * v[j].y) + (v[j].z * v[j].z + v[j].w * v[j].w); }
            const float r = 1.0f / sqrtf(wave_sum(s, lane) * (1.f / 2048.f) + 1e-6f);
#pragma unroll
            for (int j = 0; j < 8; ++j) { const f32x4 gg = *(const GASP f32x4*)(final_g + 256 * j + 4 * lane); xr[64 * j] = (v[j] * r) * gg; }
        }
    }
}

extern "C" void kernel_launch(void* const* d_in, const int* in_sizes, int n_in, void* d_out, int out_size, void* d_ws, size_t ws_size, hipStream_t stream) {
    static int grid = 0;
    if (grid == 0) {
        if (n_in != 24 || out_size != NTOK * DMODEL || ws_size < WS_END) { fprintf(stderr, "kernel_launch: unexpected shapes (n_in %d out %d ws %zu); nothing launched\n", n_in, out_size, ws_size); grid = -1; return; }
        int dev = 0, cus = 0, per_cu = 0;
        if (hipGetDevice(&dev) != hipSuccess || hipDeviceGetAttribute(&cus, hipDeviceAttributeMultiprocessorCount, dev) != hipSuccess) { grid = -1; return; }
        if (hipFuncSetAttribute((const void*)fwd_kernel, hipFuncAttributeMaxDynamicSharedMemorySize, LDS_BYTES) != hipSuccess) { fprintf(stderr, "kernel_launch: hipFuncSetAttribute failed\n"); grid = -1; return; }
        if (hipOccupancyMaxActiveBlocksPerMultiprocessor(&per_cu, (const void*)fwd_kernel, NWAVES * 64, LDS_BYTES) != hipSuccess || per_cu < 1) { fprintf(stderr, "kernel_launch: occupancy query says %d blocks per CU\n", per_cu); per_cu = 1; }
        (void)hipGetLastError();
        grid = cus;
    }
    if (grid < 0) return;
    Args a{};
    for (int i = 0; i < 24; ++i) a.in[i] = d_in[i];
    a.out = (float*)d_out; a.ws = (unsigned char*)d_ws;
    void* kargs[] = {&a};
    const hipError_t e = hipLaunchCooperativeKernel((const void*)fwd_kernel, dim3(grid), dim3(NWAVES * 64), kargs, LDS_BYTES, stream);
    if (e != hipSuccess) fprintf(stderr, "kernel_launch: cooperative launch failed: %s (grid %d)\n", hipGetErrorString(e), grid);
}
```

```cpp
#include <hip/hip_runtime.h>
#include <hip/hip_cooperative_groups.h>
#include <cstdio>
#include <cstdint>
namespace cg = cooperative_groups;
#define GASP __attribute__((address_space(1)))
constexpr int BATCH = 8, SEQ = 4096, DMODEL = 2048, NTOK = BATCH * SEQ, DEPTH = 4, INW = 6144;
constexpr int NWAVES = 8;
constexpr size_t MiB = 1u << 20;
constexpr size_t WS_MOD = 0;
constexpr size_t WS_ROPEC = 1 * MiB, WS_ROPES = 5 * MiB;
constexpr size_t WS_S5W = 10 * MiB, S5W_LAYER = 16 * MiB, S5W2_OFF = 4 * MiB;
constexpr size_t WS_WIN = 74 * MiB, WS_WOUT = 170 * MiB, WS_WGLU = 202 * MiB;
constexpr size_t WS_H = 218 * MiB;
constexpr size_t WS_A2 = 346 * MiB;
constexpr size_t WS_E = 474 * MiB;
constexpr size_t WS_ZS = 538 * MiB, WS_Q = 602 * MiB, WS_K = 666 * MiB, WS_V = 730 * MiB, WS_ZA = 794 * MiB, WS_BIAS = 858 * MiB, WS_END = 860 * MiB;
constexpr size_t WS_SS = 9 * MiB;
constexpr int LDS_BYTES = 135168;

namespace pg8 {
#define PG8_LAS __attribute__((address_space(3)))
typedef unsigned short bf16_t;
typedef short bf16x8 __attribute__((ext_vector_type(8)));
typedef float f32x4 __attribute__((ext_vector_type(4)));
typedef unsigned u32x4 __attribute__((ext_vector_type(4)));
constexpr int BM = 256, BK = 64, HALF = 128, HTB = HALF * BK * 2  , STAGE_BYTES = 8 * HTB, NXCD = 8, WGM = 8;

__host__ __device__ __forceinline__ int lds_byte(int r, int c) { const int st = (r >> 4) * 2 + (c >> 5), rr = r & 15, cc = c & 31, ob = rr * 64 + cc * 2; return st * 1024 + (ob ^ (((ob >> 9) & 1) << 5)); }
__host__ __device__ __forceinline__ void stage_rc(int b, int& R, int& C) { const int st = b / 1024, sb = b % 1024, swz = sb ^ (((sb >> 9) & 1) << 5); R = (st >> 1) * 16 + swz / 64; C = (st & 1) * 32 + (swz % 64) / 2; }
__host__ __device__ __forceinline__ int perm32(int rho) { const int n = rho >> 4, i = rho & 15; return 8 * (i >> 2) + 4 * n + (i & 3); }

struct Unit { int pm, pn; };
struct Gemm { const bf16_t* A; const bf16_t* Bt; int M, N, K, lda, ldb, grp_tiles, grp_brows; };

struct StaticOrder {
    int nM, nN, nwg, G, c;
    __host__ __device__ void init(int M, int N, int G_, int c_) { nM = M / BM; nN = N / BM; nwg = nM * nN; G = G_; c = c_; }
    __host__ __device__ bool next(int i, Unit& u) const {
        const long L = (long)i * G + c; if (L >= nwg) return false;
        int wgid = (int)L; { const int q = nwg / NXCD, r = nwg % NXCD, xcd = wgid % NXCD, off = wgid / NXCD; wgid = (xcd < r ? xcd * (q + 1) : r * (q + 1) + (xcd - r) * q) + off; }
        const int nig = WGM * nN, gid = wgid / nig, fm = gid * WGM, gsz = (nM - fm) < WGM ? (nM - fm) : WGM;
        u.pm = fm + ((wgid % nig) % gsz); u.pn = (wgid % nig) / gsz; return true;
    }
    __device__ __forceinline__ void a_ready(const Unit&) const {}
    __device__ __forceinline__ void done(const Unit&) const {}
};


__device__ __forceinline__ unsigned cvt_pk_bf16(float lo, float hi) { unsigned r; asm volatile("v_cvt_pk_bf16_f32 %0, %1, %2" : "=v"(r) : "v"(lo), "v"(hi)); return r; }
__device__ __forceinline__ u32x4 pack8(f32x4 a, f32x4 b) { u32x4 w; w.x = cvt_pk_bf16(a[0], a[1]); w.y = cvt_pk_bf16(a[2], a[3]); w.z = cvt_pk_bf16(b[0], b[1]); w.w = cvt_pk_bf16(b[2], b[3]); return w; }
__device__ __forceinline__ void unpack8(u32x4 w, f32x4& a, f32x4& b) {
    a[0] = __uint_as_float(w.x << 16); a[1] = __uint_as_float(w.x & 0xffff0000u); a[2] = __uint_as_float(w.y << 16); a[3] = __uint_as_float(w.y & 0xffff0000u);
    b[0] = __uint_as_float(w.z << 16); b[1] = __uint_as_float(w.z & 0xffff0000u); b[2] = __uint_as_float(w.w << 16); b[3] = __uint_as_float(w.w & 0xffff0000u); }
__device__ __forceinline__ float sigmoid_f(float x) { return __builtin_amdgcn_rcpf(1.f + __builtin_amdgcn_exp2f(-1.4426950408889634f * x)); }
__device__ __forceinline__ float silu_f(float x) { return x * sigmoid_f(x); }
__device__ __forceinline__ float gelu_tanh_f(float x) { return x * sigmoid_f(1.5957691216057308f * (x + 0.044715f * x * x * x)); }
__device__ __forceinline__ f32x4 silu4(f32x4 v) { return (f32x4){silu_f(v[0]), silu_f(v[1]), silu_f(v[2]), silu_f(v[3])}; }
__device__ __forceinline__ f32x4 gelu4(f32x4 v) { return (f32x4){gelu_tanh_f(v[0]), gelu_tanh_f(v[1]), gelu_tanh_f(v[2]), gelu_tanh_f(v[3])}; }
__device__ __forceinline__ f32x4 sigm4(f32x4 v) { return (f32x4){sigmoid_f(v[0]), sigmoid_f(v[1]), sigmoid_f(v[2]), sigmoid_f(v[3])}; }

constexpr float QK_C2 = 0.125f * 1.4426950408889634f;
constexpr int A2_LD = 384;

struct EpiInProj {
    static constexpr bool PERM = true, AFTER_DRAIN = false;
    unsigned char* ws; int l;
    __device__ __forceinline__ void operator()(const f32x4 (&acc_)[2][2][4][2], const Unit& u, int wr, int wc, int fr, int fq) const {
        unsigned char* w = ws; asm volatile("" : "+s"(w));
        f32x4 acc[2][2][4][2];
        { const GASP float* ssp = (const GASP float*)(w + WS_SS) + (l & 1) * 32768 + u.pm * BM + wr * 64 + fr; const float* bp = (const float*)(w + WS_BIAS) + ((size_t)l * 8 + (u.pm >> 4)) * 6144 + u.pn * BM + 32 * wc + 8 * fq;
          f32x4 bs[2][2];
_Pragma("unroll") for (int bj = 0; bj < 2; ++bj) _Pragma("unroll") for (int n = 0; n < 2; ++n) bs[bj][n] = *(const GASP f32x4*)(bp + bj * HALF + 4 * n);
          float sv[2][4];
_Pragma("unroll") for (int ai = 0; ai < 2; ++ai) _Pragma("unroll") for (int m = 0; m < 4; ++m) sv[ai][m] = ssp[ai * HALF + m * 16];
          asm volatile("" : "+v"(sv[0][0]), "+v"(sv[0][1]), "+v"(sv[0][2]), "+v"(sv[0][3]), "+v"(sv[1][0]), "+v"(sv[1][1]), "+v"(sv[1][2]), "+v"(sv[1][3]));
_Pragma("unroll") for (int ai = 0; ai < 2; ++ai) _Pragma("unroll") for (int m = 0; m < 4; ++m) { const float rr = __builtin_amdgcn_rsqf(sv[ai][m] * (1.f / 2048.f) + 1e-6f);
_Pragma("unroll") for (int bj = 0; bj < 2; ++bj) _Pragma("unroll") for (int n = 0; n < 2; ++n) acc[ai][bj][m][n] = acc_[ai][bj][m][n] * rr + bs[bj][n]; } }
        bf16_t* A2 = (bf16_t*)(w + WS_A2); const float* ropec = (const float*)(w + WS_ROPEC); const float* ropes = (const float*)(w + WS_ROPES);
        const int seg = u.pn >> 2, colt = (u.pn & 3) * 256, row0 = u.pm * BM + wr * 64 + fr;
        if (seg == 2 || seg == 3) {
            bf16_t* O = (bf16_t*)(w + ((seg == 2) ? WS_Q : WS_K)); const float sc = (seg == 2) ? QK_C2 : 1.f;
#pragma unroll
            for (int ai = 0; ai < 2; ++ai) {
                f32x4 tc0[4], tc1[4], ts0[4], ts1[4];
#pragma unroll
                for (int m = 0; m < 4; ++m) { const size_t tr = (size_t)(row0 + ai * HALF + m * 16) * 32 + 8 * fq;
                    tc0[m] = *(const GASP f32x4*)(ropec + tr); tc1[m] = *(const GASP f32x4*)(ropec + tr + 4); ts0[m] = *(const GASP f32x4*)(ropes + tr); ts1[m] = *(const GASP f32x4*)(ropes + tr + 4); }
#pragma unroll
                for (int m = 0; m < 4; ++m) { const int row = row0 + ai * HALF + m * 16;
                    const f32x4 c0 = tc0[m], c1 = tc1[m], s0 = ts0[m], s1 = ts1[m];
                    const f32x4 a0 = acc[ai][0][m][0], a1 = acc[ai][0][m][1], b0 = acc[ai][1][m][0], b1 = acc[ai][1][m][1];
                    const f32x4 o10 = (a0 * c0 - b0 * s0) * sc, o11 = (a1 * c1 - b1 * s1) * sc, o20 = (b0 * c0 + a0 * s0) * sc, o21 = (b1 * c1 + a1 * s1) * sc;
                    bf16_t* p = O + (size_t)row * 1024 + colt + 64 * wc + 8 * fq;
                    *(GASP u32x4*)p = pack8(o10, o11); *(GASP u32x4*)(p + 32) = pack8(o20, o21); } }
        } else if (seg == 0) {
#pragma unroll
            for (int ai = 0; ai < 2; ++ai)
#pragma unroll
                for (int m = 0; m < 4; ++m) { const int row = row0 + ai * HALF + m * 16;
#pragma unroll
                    for (int bj = 0; bj < 2; ++bj) { const int col = colt + bj * HALF + 32 * wc + 8 * fq, g = col >> 4, p0 = col & 15;
                        *(GASP u32x4*)(A2 + ((size_t)(g * 2048 + (row >> 4)) * A2_LD + (row & 15) * 16 + p0)) = pack8(acc[ai][bj][m][0], acc[ai][bj][m][1]); } }
        } else {
            bf16_t* O = (bf16_t*)(w + ((seg == 1) ? WS_ZS : (seg == 4) ? WS_V : WS_ZA)); const bool act = (seg != 4);
#pragma unroll
            for (int ai = 0; ai < 2; ++ai)
#pragma unroll
                for (int m = 0; m < 4; ++m) { const int row = row0 + ai * HALF + m * 16;
#pragma unroll
                    for (int bj = 0; bj < 2; ++bj) { f32x4 v0 = acc[ai][bj][m][0], v1 = acc[ai][bj][m][1];
                        if (act) { v0 = silu4(v0); v1 = silu4(v1); }
                        *(GASP u32x4*)(O + (size_t)row * 1024 + colt + bj * HALF + 32 * wc + 8 * fq) = pack8(v0, v1); } }
        }
    }
};
struct EpiS5P1 {
    static constexpr bool PERM = true, AFTER_DRAIN = false;
    unsigned char* ws;
    __device__ __forceinline__ void operator()(const f32x4 (&acc)[2][2][4][2], const Unit& u, int wr, int wc, int fr, int fq) const {
        unsigned char* w = ws; asm volatile("" : "+s"(w)); float* E = (float*)(w + WS_H);
        const int row0 = u.pm * BM + wr * 64 + fr;
#pragma unroll
        for (int ai = 0; ai < 2; ++ai)
#pragma unroll
            for (int m = 0; m < 4; ++m) { float* p = E + (size_t)(row0 + ai * HALF + m * 16) * 128 + 32 * wc + 8 * fq;
                *(GASP f32x4*)p = acc[ai][0][m][0]; *(GASP f32x4*)(p + 4) = acc[ai][0][m][1]; }
    }
};
struct EpiS5P2 {
    static constexpr bool PERM = true, AFTER_DRAIN = false;
    unsigned char* ws;
    __device__ __forceinline__ void operator()(const f32x4 (&acc)[2][2][4][2], const Unit& u, int wr, int wc, int fr, int fq) const {
        unsigned char* w = ws; asm volatile("" : "+s"(w)); bf16_t* YG = (bf16_t*)(w + WS_E);
        const int g = u.pm >> 3, crow0 = (u.pm & 7) * BM + wr * 64 + fr;
#pragma unroll
        for (int ai = 0; ai < 2; ++ai)
#pragma unroll
            for (int m = 0; m < 4; ++m) { const int crow = crow0 + ai * HALF + m * 16;
#pragma unroll
                for (int bj = 0; bj < 2; ++bj) { const int col = bj * HALF + 32 * wc + 8 * fq, t = col >> 4, p0 = col & 15;
                    *(GASP u32x4*)(YG + (size_t)(crow * 16 + t) * 1024 + g * 16 + p0) = pack8(gelu4(acc[ai][bj][m][0]), gelu4(acc[ai][bj][m][1])); } }
    }
};
struct EpiGlu {
    static constexpr bool PERM = true, AFTER_DRAIN = false;
    unsigned char* ws; const float* bias;
    __device__ __forceinline__ void operator()(const f32x4 (&acc)[2][2][4][2], const Unit& u, int wr, int wc, int fr, int fq) const {
        unsigned char* w = ws; asm volatile("" : "+s"(w)); bf16_t* YCAT = (bf16_t*)(w + WS_A2); const bf16_t* ZS = (const bf16_t*)(w + WS_ZS);
        const int row0 = u.pm * BM + wr * 64 + fr, col = u.pn * 128 + 32 * wc + 8 * fq;
        const f32x4 ba0 = *(const GASP f32x4*)(bias + col), ba1 = *(const GASP f32x4*)(bias + col + 4), bb0 = *(const GASP f32x4*)(bias + 1024 + col), bb1 = *(const GASP f32x4*)(bias + 1024 + col + 4);
        u32x4 zr[2][4];
#pragma unroll
        for (int ai = 0; ai < 2; ++ai)
#pragma unroll
            for (int m = 0; m < 4; ++m) zr[ai][m] = *(const GASP u32x4*)(ZS + (size_t)(row0 + ai * HALF + m * 16) * 1024 + col);
#pragma unroll
        for (int ai = 0; ai < 2; ++ai)
#pragma unroll
            for (int m = 0; m < 4; ++m) { const int row = row0 + ai * HALF + m * 16;
                f32x4 z0, z1; unpack8(zr[ai][m], z0, z1);
                const f32x4 o0 = (acc[ai][0][m][0] + ba0) * sigm4(acc[ai][1][m][0] + bb0) * z0, o1 = (acc[ai][0][m][1] + ba1) * sigm4(acc[ai][1][m][1] + bb1) * z1;
                *(GASP u32x4*)(YCAT + (size_t)row * 2048 + col) = pack8(o0, o1); }
    }
};
struct EpiOut {
    static constexpr bool PERM = true, AFTER_DRAIN = false;
    const float* xin; float* xout; unsigned char* ws; const float* ng_next; int l;
    __device__ __forceinline__ void operator()(const f32x4 (&acc)[2][2][4][2], const Unit& u, int wr, int wc, int fr, int fq) const {
        unsigned char* w = ws; asm volatile("" : "+s"(w));
        const float* modl = (const float*)(w + WS_MOD) + (size_t)l * 8 * 6144; const float* modn = modl + 8 * 6144;
        bf16_t* XG = (bf16_t*)(w + WS_H);
        const int row0 = u.pm * BM + wr * 64 + fr, b = u.pm >> 4; const bool nxt = l < 3;
        float part[2][4];
#pragma unroll
        for (int ai = 0; ai < 2; ++ai)
#pragma unroll
            for (int m = 0; m < 4; ++m) part[ai][m] = 0.f;
#pragma unroll
        for (int bj = 0; bj < 2; ++bj) { const int col = u.pn * BM + bj * HALF + 32 * wc + 8 * fq;
            const f32x4 g0 = *(const GASP f32x4*)(modl + (size_t)b * 6144 + 4096 + col), g1 = *(const GASP f32x4*)(modl + (size_t)b * 6144 + 4096 + col + 4);
            f32x4 gm0 = g0, gm1 = g1;
            if (nxt) { gm0 = *(const GASP f32x4*)(ng_next + col) * (*(const GASP f32x4*)(modn + (size_t)b * 6144 + 2048 + col) + 1.f); gm1 = *(const GASP f32x4*)(ng_next + col + 4) * (*(const GASP f32x4*)(modn + (size_t)b * 6144 + 2048 + col + 4) + 1.f); }
#pragma unroll
            for (int ai = 0; ai < 2; ++ai) {
                f32x4 xa[4], xb[4];
#pragma unroll
                for (int m = 0; m < 4; ++m) { const size_t off = (size_t)(row0 + ai * HALF + m * 16) * 2048 + col; xa[m] = *(const GASP f32x4*)(xin + off); xb[m] = *(const GASP f32x4*)(xin + off + 4); }
#pragma unroll
                for (int m = 0; m < 4; ++m) { const size_t off = (size_t)(row0 + ai * HALF + m * 16) * 2048 + col;
                    const f32x4 x0 = xa[m], x1 = xb[m];
                    const f32x4 y0 = x0 + g0 * acc[ai][bj][m][0], y1 = x1 + g1 * acc[ai][bj][m][1];
                    *(GASP f32x4*)(xout + off) = y0; *(GASP f32x4*)(xout + off + 4) = y1;
                    if (nxt) { part[ai][m] += (y0[0] * y0[0] + y0[1] * y0[1]) + (y0[2] * y0[2] + y0[3] * y0[3]) + (y1[0] * y1[0] + y1[1] * y1[1]) + (y1[2] * y1[2] + y1[3] * y1[3]);
                        *(GASP u32x4*)(XG + off) = pack8(y0 * gm0, y1 * gm1); } } } }
        if (nxt) { const int lane = fr + 16 * fq; float* ssn = (float*)(w + WS_SS) + ((l + 1) & 1) * 32768 + row0;
            float sr[2][4];
#pragma unroll
            for (int ai = 0; ai < 2; ++ai)
#pragma unroll
                for (int m = 0; m < 4; ++m) { float s = part[ai][m];
                    s += __int_as_float(__builtin_amdgcn_ds_bpermute((lane ^ 16) << 2, __float_as_int(s))); s += __int_as_float(__builtin_amdgcn_ds_bpermute((lane ^ 32) << 2, __float_as_int(s))); sr[ai][m] = s; }
            const float v0 = (fq == 0) ? sr[0][0] : (fq == 1) ? sr[0][2] : (fq == 2) ? sr[1][0] : sr[1][2];
            const float v1 = (fq == 0) ? sr[0][1] : (fq == 1) ? sr[0][3] : (fq == 2) ? sr[1][1] : sr[1][3];
            float* p0 = ssn + (fq >> 1) * HALF + (fq & 1) * 32;
            (void)__builtin_amdgcn_global_atomic_fadd_f32((__attribute__((address_space(1))) float*)p0, v0);
            (void)__builtin_amdgcn_global_atomic_fadd_f32((__attribute__((address_space(1))) float*)(p0 + 16), v1); }
    }
};
template <class Epi, class Sched, bool ALIGN_EPI = false, bool SP2 = false>
__device__ __forceinline__ void gemm_phase(PG8_LAS unsigned char* lds, const Gemm g, const Sched& S, const Epi& E, const int tid) {
    const int wid = __builtin_amdgcn_readfirstlane(tid >> 6), lane = tid & 63, wr = wid >> 2, wc = wid & 3, fr = lane & 15, fq = lane >> 4;
    const int K = g.K, nt = K / BK;
    unsigned voffA[2], voffB[2];
#pragma unroll
    for (int i = 0; i < 2; ++i) { int R, C; stage_rc(tid * 16 + i * 8192, R, C); const int Rb = Epi::PERM ? ((R & ~31) + perm32(R & 31)) : R;
        voffA[i] = (unsigned)(R * g.lda + C) * 2u; voffB[i] = (unsigned)(Rb * g.ldb + C) * 2u; }
    const size_t kstep = (size_t)(BK * 2);
    const size_t hstepA = (size_t)HALF * g.lda * 2, hstepB = (size_t)HALF * g.ldb * 2;
    const unsigned ldsw = (unsigned)wid * 1024u;
    const int aoff = lds_byte(wr * 64 + fr, fq * 8), boff = lds_byte(wc * 32 + fr, fq * 8);
#define PG8_SA(b, h) (((b) * 2 + (h)) * HTB)
#define PG8_SB(b, h) ((4 + (b) * 2 + (h)) * HTB)
#define PG8_STAGE(bufoff, gbase, voff) do { _Pragma("unroll") for (int _i = 0; _i < 2; ++_i) \
        __builtin_amdgcn_global_load_lds((const unsigned*)((const char*)(gbase) + (voff)[_i]), (PG8_LAS unsigned*)(lds + (bufoff) + ldsw + _i * 8192), 16, 0, 0); } while (0)
#define PG8_LDA(dst, b, h) do { _Pragma("unroll") for (int m = 0; m < 4; ++m) _Pragma("unroll") for (int k = 0; k < 2; ++k) dst[m][k] = *(const PG8_LAS bf16x8*)(lds + PG8_SA(b, h) + aoff + m * 2048 + k * 1024); } while (0)
#define PG8_LDB(dst, b, h) do { _Pragma("unroll") for (int n = 0; n < 2; ++n) _Pragma("unroll") for (int k = 0; k < 2; ++k) dst[n][k] = *(const PG8_LAS bf16x8*)(lds + PG8_SB(b, h) + boff + n * 2048 + k * 1024); } while (0)
#define PG8_MMA(ai, bj, At, Bt) do { __builtin_amdgcn_s_setprio(1); _Pragma("unroll") for (int m = 0; m < 4; ++m) _Pragma("unroll") for (int n = 0; n < 2; ++n) _Pragma("unroll") for (int k = 0; k < 2; ++k) \
        acc[ai][bj][m][n] = __builtin_amdgcn_mfma_f32_16x16x32_bf16(Bt[n][k], At[m][k], acc[ai][bj][m][n], 0, 0, 0); __builtin_amdgcn_s_setprio(0); } while (0)
#define PG8_WAIT_V(n) asm volatile("s_waitcnt vmcnt(" #n ")" ::: "memory")
#define PG8_WAIT_L(n) asm volatile("s_waitcnt lgkmcnt(" #n ")" ::: "memory")
#define PG8_BAR __builtin_amdgcn_s_barrier()
#define PG8_SCHED __builtin_amdgcn_sched_barrier(0)
    Unit cur, nxt; int ui = 0;
    if (!S.next(0, cur)) return;
    f32x4 acc[2][2][4][2];
#pragma unroll
    for (int a = 0; a < 2; ++a)
#pragma unroll
        for (int b = 0; b < 2; ++b)
#pragma unroll
            for (int m = 0; m < 4; ++m)
#pragma unroll
                for (int n = 0; n < 2; ++n) acc[a][b][m][n] = (f32x4){0.f, 0.f, 0.f, 0.f};
    bf16x8 At[4][2], B0[2][2], B1[2][2];
    const char* cA = (const char*)g.A + (size_t)cur.pm * 2 * hstepA; const char* cB = (const char*)g.Bt + ((size_t)(cur.pm / g.grp_tiles) * g.grp_brows + (size_t)cur.pn * BM) * g.ldb * 2;
    S.a_ready(cur);
    if constexpr (SP2) {
        PG8_STAGE(PG8_SB(0, 0), cB, voffB); PG8_STAGE(PG8_SB(0, 1), cB + hstepB, voffB); PG8_STAGE(PG8_SA(0, 0), cA, voffA); PG8_STAGE(PG8_SA(0, 1), cA + hstepA, voffA);
        if (wr == 1) PG8_BAR;
        PG8_WAIT_V(2); PG8_BAR;
        PG8_STAGE(PG8_SB(1, 0), cB + kstep, voffB); PG8_STAGE(PG8_SA(1, 0), cA + kstep, voffA); PG8_STAGE(PG8_SB(1, 1), cB + hstepB + kstep, voffB);
        PG8_WAIT_V(6); PG8_BAR;
    } else {
        PG8_STAGE(PG8_SB(0, 0), cB, voffB); PG8_STAGE(PG8_SA(0, 0), cA, voffA); PG8_STAGE(PG8_SB(0, 1), cB + hstepB, voffB); PG8_STAGE(PG8_SA(0, 1), cA + hstepA, voffA);
        if (wr == 1) PG8_BAR;
        PG8_WAIT_V(4); PG8_BAR;
        PG8_STAGE(PG8_SB(1, 0), cB + kstep, voffB); PG8_STAGE(PG8_SA(1, 0), cA + kstep, voffA); PG8_STAGE(PG8_SB(1, 1), cB + hstepB + kstep, voffB);
        PG8_WAIT_V(6); PG8_BAR;
    }
    for (;;) {
        const bool has_next = S.next(ui + 1, nxt);
        const char* nA = has_next ? (const char*)g.A + (size_t)nxt.pm * 2 * hstepA : cA; const char* nB = has_next ? (const char*)g.Bt + ((size_t)(nxt.pm / g.grp_tiles) * g.grp_brows + (size_t)nxt.pn * BM) * g.ldb * 2 : cB;
        for (int t = 0; t < nt; t += 2) {
            const bool last = (t == nt - 2);
            const char* a1 = cA + (size_t)(t + 1) * kstep;
            const char* a2 = last ? nA : cA + (size_t)(t + 2) * kstep; const char* b2 = last ? nB : cB + (size_t)(t + 2) * kstep;
            const char* a3 = a2 + kstep; const char* b3 = b2 + kstep;
            if (last && has_next) S.a_ready(nxt);
            if constexpr (SP2) {
            PG8_LDB(B0, 0, 0); PG8_LDB(B1, 0, 1); PG8_SCHED; PG8_LDA(At, 0, 0); PG8_STAGE(PG8_SA(1, 1), a1 + hstepA, voffA);
            PG8_WAIT_V(8); PG8_WAIT_L(0); PG8_BAR; PG8_MMA(0, 0, At, B0); PG8_MMA(0, 1, At, B1); PG8_BAR; PG8_SCHED;
            PG8_LDA(At, 0, 1); PG8_STAGE(PG8_SB(0, 0), b2, voffB); PG8_STAGE(PG8_SB(0, 1), b2 + hstepB, voffB); PG8_STAGE(PG8_SA(0, 0), a2, voffA);
            PG8_WAIT_V(8); PG8_WAIT_L(0); PG8_BAR; PG8_MMA(1, 0, At, B0); PG8_MMA(1, 1, At, B1); PG8_BAR; PG8_SCHED;
            PG8_LDB(B0, 1, 0); PG8_LDB(B1, 1, 1); PG8_SCHED; PG8_LDA(At, 1, 0); PG8_STAGE(PG8_SA(0, 1), a2 + hstepA, voffA);
            PG8_WAIT_V(8); PG8_WAIT_L(0); PG8_BAR; PG8_MMA(0, 0, At, B0); PG8_MMA(0, 1, At, B1); PG8_BAR; PG8_SCHED;
            PG8_LDA(At, 1, 1); PG8_STAGE(PG8_SB(1, 0), b3, voffB); PG8_STAGE(PG8_SB(1, 1), b3 + hstepB, voffB); PG8_STAGE(PG8_SA(1, 0), a3, voffA);
            PG8_WAIT_V(8); PG8_WAIT_L(0); PG8_BAR; PG8_MMA(1, 0, At, B0); PG8_MMA(1, 1, At, B1); PG8_BAR; PG8_SCHED;
            } else {
            PG8_LDB(B0, 0, 0); PG8_SCHED; PG8_LDA(At, 0, 0); PG8_STAGE(PG8_SA(1, 1), a1 + hstepA, voffA);
            PG8_WAIT_L(8); PG8_BAR; PG8_WAIT_L(0); PG8_MMA(0, 0, At, B0); PG8_BAR; PG8_SCHED;
            PG8_LDB(B1, 0, 1); PG8_STAGE(PG8_SB(0, 0), b2, voffB);
            PG8_BAR; PG8_WAIT_L(0); PG8_MMA(0, 1, At, B1); PG8_BAR;
            PG8_LDA(At, 0, 1); PG8_STAGE(PG8_SA(0, 0), a2, voffA);
            PG8_BAR; PG8_WAIT_L(0); PG8_MMA(1, 0, At, B0); PG8_BAR; PG8_SCHED;
            PG8_STAGE(PG8_SB(0, 1), b2 + hstepB, voffB);
            PG8_WAIT_V(6); PG8_BAR; PG8_MMA(1, 1, At, B1); PG8_BAR;
            PG8_LDB(B0, 1, 0); PG8_SCHED; PG8_LDA(At, 1, 0); PG8_STAGE(PG8_SA(0, 1), a2 + hstepA, voffA);
            PG8_WAIT_L(8); PG8_BAR; PG8_WAIT_L(0); PG8_MMA(0, 0, At, B0); PG8_BAR; PG8_SCHED;
            PG8_LDB(B1, 1, 1); PG8_STAGE(PG8_SB(1, 0), b3, voffB);
            PG8_BAR; PG8_WAIT_L(0); PG8_MMA(0, 1, At, B1); PG8_BAR;
            PG8_LDA(At, 1, 1); PG8_STAGE(PG8_SA(1, 0), a3, voffA);
            PG8_BAR; PG8_WAIT_L(0); PG8_MMA(1, 0, At, B0); PG8_BAR; PG8_SCHED;
            PG8_STAGE(PG8_SB(1, 1), b3 + hstepB, voffB);
            PG8_WAIT_V(6); PG8_BAR; PG8_MMA(1, 1, At, B1); PG8_BAR;
            }
        }
        if constexpr (ALIGN_EPI) { if (wr == 0) PG8_BAR; }
        if constexpr (!Epi::AFTER_DRAIN) { int wr_e = wr, wc_e = wc, fr_e = fr, fq_e = fq; asm volatile("" : "+s"(wr_e), "+s"(wc_e), "+v"(fr_e), "+v"(fq_e)); E(acc, cur, wr_e, wc_e, fr_e, fq_e); S.done(cur); }
        if (!has_next) break;
#pragma unroll
        for (int a = 0; a < 2; ++a)
#pragma unroll
            for (int b = 0; b < 2; ++b)
#pragma unroll
                for (int m = 0; m < 4; ++m)
#pragma unroll
                    for (int n = 0; n < 2; ++n) acc[a][b][m][n] = (f32x4){0.f, 0.f, 0.f, 0.f};
        cur = nxt; cA = nA; cB = nB; ++ui;
        if constexpr (ALIGN_EPI) { if (wr == 1) PG8_BAR; }
    }
    PG8_WAIT_V(0);
    if constexpr (!ALIGN_EPI) { if (wr == 0) PG8_BAR; }
    PG8_BAR;
    if constexpr (Epi::AFTER_DRAIN) { E.fused(acc, cur, wr, wc, fr, fq, lds, wid, lane); S.done(cur); }
#undef PG8_SA
#undef PG8_SB
#undef PG8_STAGE
#undef PG8_LDA
#undef PG8_LDB
#undef PG8_MMA
#undef PG8_WAIT_V
#undef PG8_WAIT_L
#undef PG8_BAR
#undef PG8_SCHED
}
}
#include <hip/hip_bf16.h>
#include <cmath>
namespace attn_body {
using bf16=__hip_bfloat16;
using bf16x8=__attribute__((ext_vector_type(8)))short;
using s16x4=__attribute__((ext_vector_type(4)))short;
using f32x16=__attribute__((ext_vector_type(16)))float;
using u32x4=__attribute__((ext_vector_type(4)))unsigned;
constexpr int BATCH=8,NHEAD=16,SEQ=4096,D=64,DM=NHEAD*D;
constexpr int NW=8,QBLK=32,QB=QBLK*NW,KVBLK=64,NQB=SEQ/QB;
constexpr int ATTN_PITCH=DM, ATTN_UNIT_ROWS=QB;
__device__ __forceinline__ int crow(int r,int hi){return (r&3)+8*(r>>2)+4*hi;}
#define SBAR() __builtin_amdgcn_sched_barrier(0)
__device__ __forceinline__ void cmask(f32x16&p0,f32x16&p1,int jb,int qrel,int hi){
  const float NEG=-INFINITY; int kb=64*jb+4*hi;
  #pragma unroll
  for(int r=0;r<16;++r){int kv=kb+(r&3)+8*(r>>2); if(kv>qrel)p0[r]=NEG; if(kv+32>qrel)p1[r]=NEG;}
}

constexpr int NSLOT=3, SLOTB=8192;
constexpr int LDS_K=0, LDS_V=NSLOT*SLOTB, LDS_WS=2*NSLOT*SLOTB, LDS_OST=LDS_WS+NW*64*4, LDS_BYTES=LDS_OST+NW*4096;
constexpr float C2=0.125f*1.4426950408889634f;
__device__ __forceinline__ void glds16(const void*gsrc,unsigned lds_dst){unsigned keep;
  asm volatile("s_mov_b32 %0, m0\n\ts_mov_b32 m0, %2\n\ts_nop 0\n\tglobal_load_lds_dwordx4 %1, off\n\ts_mov_b32 m0, %0":"=&s"(keep):"v"(gsrc),"s"(lds_dst):"memory");}
__device__ __forceinline__ float max3f(float a,float b,float c){float r;asm("v_max3_f32 %0, %1, %2, %3":"=v"(r):"v"(a),"v"(b),"v"(c));return r;}
__device__ __forceinline__ float max2f(float a,float b){float r;asm("v_max_f32_e32 %0, %1, %2":"=v"(r):"v"(a),"v"(b));return r;}
__device__ __forceinline__ float fadd_s(float a,float b){float r;asm("v_add_f32_e32 %0, %1, %2":"=v"(r):"v"(a),"v"(b));return r;}
__device__ __forceinline__ float fsub_s(float a,float b){float r;asm("v_sub_f32_e32 %0, %1, %2":"=v"(r):"v"(a),"v"(b));return r;}
typedef float f32x2_t __attribute__((ext_vector_type(2))); typedef __bf16 bf16x2_t __attribute__((ext_vector_type(2)));
__device__ __forceinline__ unsigned cvtpk_s(float lo,float hi){f32x2_t v={lo,hi};bf16x2_t b=__builtin_convertvector(v,bf16x2_t);return __builtin_bit_cast(unsigned,b);}
#define WAIT_BAR(N) asm volatile("s_waitcnt vmcnt(" #N ") lgkmcnt(0)\n\ts_barrier":::"memory")

__device__ __forceinline__ void qkt(f32x16&p0,f32x16&p1,const char*Kslot,const bf16x8*qr,const f32x16&negm,int r32,int hi){
  const char*kb=Kslot+hi*1024+r32*16;
  #pragma unroll
  for(int d0=0;d0<4;++d0){
    const bf16x8 b0=*reinterpret_cast<const bf16x8*>(kb+d0*2048);
    const bf16x8 b1=*reinterpret_cast<const bf16x8*>(kb+d0*2048+512);
    if(d0==0){p0=__builtin_amdgcn_mfma_f32_32x32x16_bf16(b0,qr[0],negm,0,0,0);p1=__builtin_amdgcn_mfma_f32_32x32x16_bf16(b1,qr[0],negm,0,0,0);}
    else{p0=__builtin_amdgcn_mfma_f32_32x32x16_bf16(b0,qr[d0],p0,0,0,0);p1=__builtin_amdgcn_mfma_f32_32x32x16_bf16(b1,qr[d0],p1,0,0,0);}}
}
typedef __attribute__((address_space(3))) const char* lds_cptr;
typedef short v4i16_t __attribute__((ext_vector_type(4)));
__device__ __forceinline__ void kload8(bf16x8*kf,lds_cptr kp){
  kf[0]=*(const __attribute__((address_space(3))) bf16x8*)(kp);      kf[1]=*(const __attribute__((address_space(3))) bf16x8*)(kp+512);
  kf[2]=*(const __attribute__((address_space(3))) bf16x8*)(kp+2048); kf[3]=*(const __attribute__((address_space(3))) bf16x8*)(kp+2560);
  kf[4]=*(const __attribute__((address_space(3))) bf16x8*)(kp+4096); kf[5]=*(const __attribute__((address_space(3))) bf16x8*)(kp+4608);
  kf[6]=*(const __attribute__((address_space(3))) bf16x8*)(kp+6144); kf[7]=*(const __attribute__((address_space(3))) bf16x8*)(kp+6656);
}
__device__ __forceinline__ void kload2(bf16x8*kf,lds_cptr kp,int j){ kf[2*j]=*(const __attribute__((address_space(3))) bf16x8*)(kp+j*2048); kf[2*j+1]=*(const __attribute__((address_space(3))) bf16x8*)(kp+j*2048+512); }
__device__ __forceinline__ s16x4 vtr(lds_cptr p){ return __builtin_bit_cast(s16x4,__builtin_amdgcn_ds_read_tr16_b64_v4i16((__attribute__((address_space(3))) v4i16_t*)p)); }
__device__ __forceinline__ float rowmax(const f32x16&p0,const f32x16&p1){
  float a=max3f(p0[0],p0[1],p1[0]),b=max3f(p0[2],p0[3],p1[1]);a=max3f(a,p1[2],p1[3]);
  #pragma unroll
  for(int r=4;r<16;r+=4){a=max3f(a,p0[r],p0[r+1]);b=max3f(b,p0[r+2],p0[r+3]);a=max3f(a,p1[r],p1[r+1]);b=max3f(b,p1[r+2],p1[r+3]);}
  const float m=max2f(a,b);
  auto rr=__builtin_amdgcn_permlane32_swap(__float_as_uint(m),__float_as_uint(m),false,false);
  return max2f(__uint_as_float(rr[0]),__uint_as_float(rr[1]));
}
__device__ __forceinline__ void pv(f32x16*o,int vb,bf16x8 pa0,bf16x8 pa1,bf16x8 pa2,bf16x8 pa3){
  #pragma unroll
  for(int d0=0;d0<2;++d0){s16x4 lo[4],hi[4];
    #pragma unroll
    for(int ks=0;ks<4;++ks){
      asm volatile("ds_read_b64_tr_b16 %0,%1 offset:%c2":"=&v"(lo[ks]):"v"(vb),"i"(d0*4096+ks*1024):"memory");
      asm volatile("ds_read_b64_tr_b16 %0,%1 offset:%c2":"=&v"(hi[ks]):"v"(vb),"i"(d0*4096+ks*1024+512):"memory");}
    asm volatile("s_waitcnt lgkmcnt(0)":::"memory");SBAR();
    #define PK(k) (bf16x8){lo[k][0],lo[k][1],lo[k][2],lo[k][3],hi[k][0],hi[k][1],hi[k][2],hi[k][3]}
    o[d0]=__builtin_amdgcn_mfma_f32_32x32x16_bf16(pa0,PK(0),o[d0],0,0,0);
    o[d0]=__builtin_amdgcn_mfma_f32_32x32x16_bf16(pa1,PK(1),o[d0],0,0,0);
    o[d0]=__builtin_amdgcn_mfma_f32_32x32x16_bf16(pa2,PK(2),o[d0],0,0,0);
    o[d0]=__builtin_amdgcn_mfma_f32_32x32x16_bf16(pa3,PK(3),o[d0],0,0,0);
    #undef PK
  }
}

#ifndef ATTN_STORE16
#define ATTN_STORE16(p,v) (*(GASP u32x4*)(p)=(v))
#endif
template<int THRL> __device__ __forceinline__ void attn_unit(int b,int qc,int vc,int qb,const bf16*Q,const bf16*__restrict__ K,const bf16*__restrict__ V,bf16*O,char*shm,const int tid){
  const int lane=tid&63,r32=lane&31,hi=lane>>5; const int wid=__builtin_amdgcn_readfirstlane(tid>>6);
  const long rowbase=(long)b*SEQ; const int q0=qb*QB;
  const bf16*Qw=Q+(rowbase+q0+wid*QBLK)*DM+qc;
  const bf16*Kh=K+rowbase*DM+qc,*Vh=V+rowbase*DM+vc;
  const unsigned lds0=(unsigned)(uintptr_t)shm;
  float*wsf=(float*)(shm+LDS_WS)+wid*64;
  const bf16*ksrc=Kh+(long)lane*DM+wid*8;
  const bf16*vsrc=Vh+(long)(16*(wid&3)+(lane>>2))*DM+(wid>>2)*32+(lane&3)*8;
  const unsigned kdst=lds0+LDS_K+wid*1024, vdst=lds0+LDS_V+wid*1024;
  #define DMA_K(t,slot) glds16(ksrc+(long)(t)*KVBLK*DM,(unsigned)__builtin_amdgcn_readfirstlane(kdst+(slot)))
  #define DMA_V(t,slot) glds16(vsrc+(long)(t)*KVBLK*DM,(unsigned)__builtin_amdgcn_readfirstlane(vdst+(slot)))
  const int vb0=(int)(lds0+LDS_V)+((lane>>4)&1)*32+(lane&3)*8+(4*hi+((lane&15)>>2))*64;
  const char*Kbase=shm+LDS_K; bf16x8 kf[8];
  const lds_cptr shm3=(lds_cptr)shm; const lds_cptr kp0=shm3+LDS_K+hi*1024+r32*16; const lds_cptr vp0=shm3+LDS_V+((lane>>4)&1)*32+(lane&3)*8+(4*hi+((lane&15)>>2))*64;
  const int NT=(q0+QB)/KVBLK;
  DMA_K(0,0);DMA_V(0,0);DMA_K(1,SLOTB);
  bf16x8 qr[4];
  #pragma unroll
  for(int d0=0;d0<4;++d0)qr[d0]=*(const GASP bf16x8*)(&Qw[(long)r32*DM+d0*16+hi*8]);
  float zf_=0.f;asm volatile("":"+v"(zf_));float mhat=zf_,l_reg=zf_;f32x16 o[2],negm;
  #pragma unroll
  for(int r=0;r<16;++r){o[0][r]=zf_;o[1][r]=zf_;negm[r]=zf_;}
  asm volatile("":"+v"(negm));
  const int qrel=wid*QBLK+r32;
  #define CMASK(P0,P1,t) do{int jb_=(t)-(NT-4); if(jb_>=0)cmask(P0,P1,jb_,qrel,hi);}while(0)
  bool resc=false;
  #define START(P0,P1) do{ const float rm=rowmax(P0,P1); resc=false; \
    { const float dl=rm; mhat=fadd_s(mhat,dl); \
      _Pragma("unroll") for(int r=0;r<16;++r){P0[r]=fsub_s(P0[r],dl);P1[r]=fsub_s(P1[r],dl);} \
      _Pragma("unroll") for(int r=0;r<16;++r)negm[r]=-mhat; asm volatile("":"+v"(negm)); } \
    _Pragma("unroll") for(int r=0;r<16;++r)P0[r]=__builtin_amdgcn_exp2f(P0[r]); }while(0)
  #define RESC() do{ if(resc){ asm volatile("s_waitcnt lgkmcnt(0)":::"memory"); \
      _Pragma("unroll") for(int d_=0;d_<2;++d_) _Pragma("unroll") for(int r=0;r<16;++r)o[d_][r]*=wsf[crow(r,hi)]; } }while(0)
  f32x16 pA0,pA1,pB0,pB1;
  int sl_prev=0,sl_cur=0,sl_next=SLOTB;
  #define ROT() do{sl_prev=sl_cur;sl_cur=sl_next;sl_next=(sl_next==(NSLOT-1)*SLOTB)?0:sl_next+SLOTB;}while(0)
  DMA_K(2,2*SLOTB);
  WAIT_BAR(3);
  qkt(pA0,pA1,Kbase,qr,negm,r32,hi);asm volatile("s_nop 15\n\ts_nop 7":"+v"(pA0),"+v"(pA1));CMASK(pA0,pA1,0);
  START(pA0,pA1);
  _Pragma("unroll") for(int r=0;r<16;++r)pA1[r]=__builtin_amdgcn_exp2f(pA1[r]);
  WAIT_BAR(0);
  DMA_K(3,0);DMA_V(1,SLOTB);
  ROT();
  kload8(kf,kp0+sl_cur);
  WAIT_BAR(2);
  s16x4 vlo[8],vhi[8]; u32x4 pw0,pw1,pw2,pw3;
  #define PKW(P,B) cvtpk_s(P[B],P[B+1])
  #define PAF(k) __builtin_bit_cast(bf16x8,pw##k)
  #define VFR(i) (bf16x8){vlo[i][0],vlo[i][1],vlo[i][2],vlo[i][3],vhi[i][0],vhi[i][1],vhi[i][2],vhi[i][3]}
  #define PIN(x) asm volatile("":"+v"(x))
  #define MX3(a,b,c) __builtin_fmaxf(__builtin_fmaxf((a),(b)),(c))
  #define GAPA(MF,A0,A1,A2,A3,W0,W1,PW) do{ MF; sacc+=A0; sacc+=A1; sacc+=A2; sacc+=A3; PIN(sacc); W0; W1; PIN(PW); SBAR(); }while(0)
  #define EX(v) __builtin_amdgcn_exp2f(v)
  #define GAPB(MF,X,B) do{ MF; X[B]=EX(X[B]); X[B+1]=EX(X[B+1]); X[B+2]=EX(X[B+2]); X[B+3]=EX(X[B+3]); PIN(X); SBAR(); }while(0)
  #define VRD(i) do{ vlo[i]=vtr(vp_+(((i)>>2)*4096+((i)&3)*1024)); vhi[i]=vtr(vp_+(((i)>>2)*4096+((i)&3)*1024+512)); }while(0)
  #define KRD(G,j) do{ if(G){ kload2(kf,kp0+sl_next,j); SBAR(); } }while(0)
  #define STEP(C0,C1,P0,P1,t,GK,GV,GL) do{ SBAR(); \
    const lds_cptr vp_=vp0+sl_prev; \
    VRD(0); SBAR(); float sacc=(P0[0]+P0[1]); \
    GAPA(C0=__builtin_amdgcn_mfma_f32_32x32x16_bf16(kf[0],qr[0],negm,0,0,0), P0[2],P0[3],P0[4],P0[5],     pw0[0]=PKW(P0,0), pw0[1]=PKW(P0,2), pw0); \
    VRD(4); SBAR(); GAPA(C1=__builtin_amdgcn_mfma_f32_32x32x16_bf16(kf[1],qr[0],negm,0,0,0), P0[6],P0[7],P0[8],P0[9],     pw0[2]=PKW(P0,4), pw0[3]=PKW(P0,6), pw0); \
    VRD(1); SBAR(); GAPA(C0=__builtin_amdgcn_mfma_f32_32x32x16_bf16(kf[2],qr[1],C0,0,0,0),   P0[10],P0[11],P0[12],P0[13], pw1[0]=PKW(P0,8), pw1[1]=PKW(P0,10), pw1); \
    VRD(5); SBAR(); GAPA(C1=__builtin_amdgcn_mfma_f32_32x32x16_bf16(kf[3],qr[1],C1,0,0,0),   P0[14],P0[15],P1[0],P1[1],   pw1[2]=PKW(P0,12),pw1[3]=PKW(P0,14), pw1); \
    VRD(2); SBAR(); GAPA(C0=__builtin_amdgcn_mfma_f32_32x32x16_bf16(kf[4],qr[2],C0,0,0,0),   P1[2],P1[3],P1[4],P1[5],     pw2[0]=PKW(P1,0), pw2[1]=PKW(P1,2), pw2); \
    VRD(6); SBAR(); GAPA(C1=__builtin_amdgcn_mfma_f32_32x32x16_bf16(kf[5],qr[2],C1,0,0,0),   P1[6],P1[7],P1[8],P1[9],     pw2[2]=PKW(P1,4), pw2[3]=PKW(P1,6), pw2); \
    VRD(3); SBAR(); GAPA(C0=__builtin_amdgcn_mfma_f32_32x32x16_bf16(kf[6],qr[3],C0,0,0,0),   P1[10],P1[11],P1[12],P1[13], pw3[0]=PKW(P1,8), pw3[1]=PKW(P1,10), pw3); \
    VRD(7); SBAR(); GAPA(C1=__builtin_amdgcn_mfma_f32_32x32x16_bf16(kf[7],qr[3],C1,0,0,0),   P1[14],P1[15],0.f,0.f,       pw3[2]=PKW(P1,12),pw3[3]=PKW(P1,14), pw3); \
    l_reg+=sacc; \
    if(GK){DMA_K((t)+3,sl_cur);} if(GV){DMA_V((t)+1,sl_next);} \
    CMASK(C0,C1,t); \
    { float a=MX3(C0[0],C0[1],C1[0]),b=MX3(C0[2],C0[3],C1[1]); a=MX3(a,C1[2],C1[3]); \
      _Pragma("unroll") for(int r=4;r<16;r+=4){a=MX3(a,C0[r],C0[r+1]);b=MX3(b,C0[r+2],C0[r+3]);a=MX3(a,C1[r],C1[r+1]);b=MX3(b,C1[r+2],C1[r+3]);} \
      float rm=__builtin_fmaxf(a,b); { auto rr=__builtin_amdgcn_permlane32_swap(__float_as_uint(rm),__float_as_uint(rm),false,false); rm=__builtin_fmaxf(__uint_as_float(rr[0]),__uint_as_float(rr[1])); } \
      resc=false; \
      if(__builtin_expect(__any(rm>(float)THRL),0)){ const float dl=__builtin_fmaxf(rm,0.f); mhat+=dl; \
        _Pragma("unroll") for(int r=0;r<16;++r){C0[r]-=dl;C1[r]-=dl;} \
        _Pragma("unroll") for(int r=0;r<16;++r)negm[r]=-mhat; asm volatile("":"+v"(negm)); \
        const float f=__builtin_amdgcn_exp2f(-dl); l_reg*=f; if(hi==0)wsf[r32]=f; resc=true; } } \
    SBAR(); \
    GAPB(o[0]=__builtin_amdgcn_mfma_f32_32x32x16_bf16(PAF(0),VFR(0),o[0],0,0,0), C0,0); \
    GAPB(o[1]=__builtin_amdgcn_mfma_f32_32x32x16_bf16(PAF(0),VFR(4),o[1],0,0,0), C0,4); \
    KRD(GL,0); GAPB(o[0]=__builtin_amdgcn_mfma_f32_32x32x16_bf16(PAF(1),VFR(1),o[0],0,0,0), C0,8); \
    KRD(GL,1); GAPB(o[1]=__builtin_amdgcn_mfma_f32_32x32x16_bf16(PAF(1),VFR(5),o[1],0,0,0), C0,12); \
    KRD(GL,2); GAPB(o[0]=__builtin_amdgcn_mfma_f32_32x32x16_bf16(PAF(2),VFR(2),o[0],0,0,0), C1,0); \
    KRD(GL,3); GAPB(o[1]=__builtin_amdgcn_mfma_f32_32x32x16_bf16(PAF(2),VFR(6),o[1],0,0,0), C1,4); \
    GAPB(o[0]=__builtin_amdgcn_mfma_f32_32x32x16_bf16(PAF(3),VFR(3),o[0],0,0,0), C1,8); \
    GAPB(o[1]=__builtin_amdgcn_mfma_f32_32x32x16_bf16(PAF(3),VFR(7),o[1],0,0,0), C1,12); \
    }while(0)
  int t=1;
  #undef CMASK
  #define CMASK(P0,P1,t) do{}while(0)
  for(;t+5<NT;t+=2){
    STEP(pB0,pB1,pA0,pA1,t,true,true,true);     WAIT_BAR(2); RESC(); ROT();
    STEP(pA0,pA1,pB0,pB1,t+1,true,true,true);   WAIT_BAR(2); RESC(); ROT();
  }
  #undef CMASK
  #define CMASK(P0,P1,t) do{int jb_=(t)-(NT-4); if(jb_>=0)cmask(P0,P1,jb_,qrel,hi);}while(0)
  #define ENDW(tt) do{ if((tt)+3<NT){WAIT_BAR(2);} else if((tt)+2<NT){WAIT_BAR(1);} else {WAIT_BAR(0);} }while(0)
  for(;t+1<NT;t+=2){
    STEP(pB0,pB1,pA0,pA1,t,(t+3<NT),(t+1<NT),(t+1<NT));       ENDW(t);   RESC(); ROT();
    STEP(pA0,pA1,pB0,pB1,t+1,(t+4<NT),(t+2<NT),(t+2<NT));     ENDW(t+1); RESC(); ROT();
  }
  STEP(pB0,pB1,pA0,pA1,NT-1,false,false,false); RESC();
  { float sacc=pB0[0]+pB0[1]; _Pragma("unroll") for(int r=2;r<16;++r)sacc+=pB0[r]; _Pragma("unroll") for(int r=0;r<16;++r)sacc+=pB1[r]; l_reg+=sacc;
    pw0=(u32x4){PKW(pB0,0),PKW(pB0,2),PKW(pB0,4),PKW(pB0,6)};pw1=(u32x4){PKW(pB0,8),PKW(pB0,10),PKW(pB0,12),PKW(pB0,14)};pw2=(u32x4){PKW(pB1,0),PKW(pB1,2),PKW(pB1,4),PKW(pB1,6)};pw3=(u32x4){PKW(pB1,8),PKW(pB1,10),PKW(pB1,12),PKW(pB1,14)};
    SBAR(); pv(o,vb0+sl_cur,PAF(0),PAF(1),PAF(2),PAF(3)); }
  #undef PKW
  #undef PAF
  #undef VFR
  #undef PIN
  #undef MX3
  #undef GAPA
  #undef GAPB
  #undef EX
  #undef VRD
  #undef KRD
  #undef STEP
  #undef ENDW
  {auto rr=__builtin_amdgcn_permlane32_swap(__float_as_uint(l_reg),__float_as_uint(l_reg),false,false);l_reg=__uint_as_float(rr[0])+__uint_as_float(rr[1]);}
  if(hi==0)wsf[32+r32]=l_reg;asm volatile("s_waitcnt lgkmcnt(0)":::"memory");
  float rli[16];
  #pragma unroll
  for(int r=0;r<16;++r)rli[r]=__builtin_amdgcn_rcpf(wsf[32+crow(r,hi)]);
  bf16*Ow=O+(rowbase+q0+wid*QBLK)*DM+vc;
  { bf16*stg=(bf16*)(shm+LDS_OST)+wid*2048;
    #pragma unroll
    for(int r=0;r<16;++r){const int orow=crow(r,hi);
      #pragma unroll
      for(int d0=0;d0<2;++d0)stg[orow*64+d0*32+r32]=__float2bfloat16(o[d0][r]*rli[r]);}
    asm volatile("s_waitcnt lgkmcnt(0)":::"memory");
    #pragma unroll
    for(int i=0;i<4;++i){const int row=i*8+(lane>>3),ch=lane&7; const u32x4 v=*(const u32x4*)(stg+row*64+ch*8); ATTN_STORE16(Ow+(long)row*DM+ch*8,v);} }
  asm volatile("s_waitcnt lgkmcnt(0)\n\ts_barrier":::"memory");
  #undef DMA_K
  #undef DMA_V
  #undef CMASK
  #undef START
  #undef RESC
  #undef ROT
}
constexpr int ATTN_LDS_BYTES=LDS_BYTES;
#undef SBAR
#undef WAIT_BAR
}

#define LAS __attribute__((address_space(3)))
typedef unsigned short bf16;
typedef unsigned v4u __attribute__((ext_vector_type(4)));
typedef unsigned v2u __attribute__((ext_vector_type(2)));
typedef float f32x4 __attribute__((ext_vector_type(4)));

__device__ __forceinline__ float lane_xor(float v, int lane, int o) { return __int_as_float(__builtin_amdgcn_ds_bpermute((lane ^ o) << 2, __float_as_int(v))); }
__device__ __forceinline__ float wave_sum(float v, int lane) {
#pragma unroll
    for (int o = 1; o < 64; o <<= 1) v += lane_xor(v, lane, o);
    return v;
}
__device__ __forceinline__ unsigned f2bf(float f) { unsigned u = __builtin_bit_cast(unsigned, f); return (u + 0x7fffu + ((u >> 16) & 1u)) >> 16; }
__device__ __forceinline__ unsigned pk2(float lo, float hi) { return f2bf(lo) | (f2bf(hi) << 16); }
__device__ __forceinline__ float bflo(unsigned w) { return __uint_as_float(w << 16); }
__device__ __forceinline__ float bfhi(unsigned w) { return __uint_as_float(w & 0xffff0000u); }
__device__ __forceinline__ void sincos_d(double ang, float& s, float& c) { double t = ang * 0.15915494309189535; t -= rint(t); const float f = (float)t; s = __builtin_amdgcn_sinf(f); c = __builtin_amdgcn_cosf(f); }

__device__ __forceinline__ void p0_transpose_item(const float* W, int K, int N, bf16* WT, int srccol0, int dstrow0, int k0, LAS float* scr, int lane) {
#pragma unroll
    for (int i = 0; i < 32; ++i) { const int kk = 2 * i + (lane >> 5); scr[kk * 33 + (lane & 31)] = W[(size_t)(k0 + kk) * N + srccol0 + (lane & 31)]; }
    asm volatile("s_waitcnt lgkmcnt(0)" ::: "memory");
    const int c = lane & 7;
#pragma unroll
    for (int j = 0; j < 4; ++j) { const int n = (lane >> 3) + 8 * j; const LAS float* s = scr + (8 * c) * 33 + n;
        v4u o; o.x = pk2(s[0 * 33], s[1 * 33]); o.y = pk2(s[2 * 33], s[3 * 33]); o.z = pk2(s[4 * 33], s[5 * 33]); o.w = pk2(s[6 * 33], s[7 * 33]);
        *(GASP v4u*)(WT + (size_t)(dstrow0 + n) * K + k0 + 8 * c) = o; }
    asm volatile("s_waitcnt lgkmcnt(0)" ::: "memory");
}
__device__ __forceinline__ int win_srccol(int r0) { const int pn = r0 >> 8, seg = pn >> 2; if (seg == 2 || seg == 3) { const int s = r0 & 255; return (pn << 8) + 64 * ((s & 127) >> 5) + 32 * (s >> 7); } return r0; }
__device__ __forceinline__ int wglu_srccol(int r0) { const int pn = r0 >> 8, s = r0 & 255; return (s >> 7) * 1024 + pn * 128 + (s & 127); }

#define XB_TMO      128
#define XB_XCNT(j)  (256  + 64 * (j))
#define XB_XSUB(j)  (1280 + 64 * (j))
#define XB_XGEN(j)  (2304 + 64 * (j))
#define XB_TOP      3328
#define XB_TOPGEN   3392
#define XCD_BAR_WORDS 3456
#define XB_SPIN_CAP (1u << 22)

__device__ __forceinline__ unsigned xb_ld(unsigned* p)              { return __hip_atomic_load(p, __ATOMIC_RELAXED, __HIP_MEMORY_SCOPE_AGENT); }
__device__ __forceinline__ unsigned xb_add(unsigned* p, unsigned v) { return __hip_atomic_fetch_add(p, v, __ATOMIC_RELAXED, __HIP_MEMORY_SCOPE_AGENT); }
__device__ __forceinline__ unsigned xb_xcc_id() { return (unsigned)__builtin_amdgcn_s_getreg((3 << 11) | 20) & 0xFu; }
#define XB_SPIN(cond, bar) do { unsigned _sp = 0; while (cond) { __builtin_amdgcn_s_sleep(1); \
    if ((++_sp & 255u) == 0u) { if (xb_ld(&(bar)[XB_TMO])) break; if (_sp > XB_SPIN_CAP) { atomicAdd(&(bar)[XB_TMO], 1u); break; } } } } while (0)

struct XcdBarrier {
    unsigned* bar; unsigned x;
    volatile LAS unsigned* st;
};

__device__ __forceinline__ XcdBarrier xcd_barrier_post(unsigned* bar, volatile LAS unsigned* st) {
    XcdBarrier b; b.bar = bar; b.x = xb_xcc_id(); b.st = st;
    if (threadIdx.x == 0) (void)xb_add(&bar[XB_XCNT(b.x)], 1u);
    return b;
}
__device__ __forceinline__ void xcd_barrier_complete(unsigned* bar, unsigned x, unsigned& nloc, unsigned& nx) {
    const unsigned G = gridDim.x * gridDim.y * gridDim.z;
    unsigned sum, cnt, mine, sp = 0u;
    for (;;) {
        sum = 0u; cnt = 0u; mine = 0u;
#pragma unroll
        for (unsigned j = 0; j < 16; ++j) { const unsigned c = xb_ld(&bar[XB_XCNT(j)]); sum += c; cnt += (c > 0u) ? 1u : 0u; mine = (j == x) ? c : mine; }
        if (sum == G) break;
        __builtin_amdgcn_s_sleep(1);
        if ((++sp & 255u) == 0u) { if (xb_ld(&bar[XB_TMO])) break; if (sp > XB_SPIN_CAP) { atomicAdd(&bar[XB_TMO], 1u); break; } }
    }
    nloc = mine > 0u ? mine : 1u; nx = cnt > 0u ? cnt : 1u;
}

__device__ __forceinline__ void xcd_barrier(const XcdBarrier& b) {
    asm volatile("s_waitcnt vmcnt(0)" ::: "memory");
    __syncthreads();
    if (threadIdx.x == 0) {
        unsigned* bar = b.bar;
        __builtin_amdgcn_s_waitcnt(0);
        unsigned nloc = b.st[0], nx = b.st[1];
        if (nloc == 0u) { xcd_barrier_complete(bar, b.x, nloc, nx); b.st[0] = nloc; b.st[1] = nx; }
        const unsigned old = xb_add(&bar[XB_XSUB(b.x)], 1u);
        const unsigned gen = old / nloc;
        if (old + 1u == (gen + 1u) * nloc) {
            __builtin_amdgcn_fence(__ATOMIC_RELEASE, "agent");
            asm volatile("s_waitcnt vmcnt(0)" ::: "memory");
            const unsigned og = xb_add(&bar[XB_TOP], 1u);
            const unsigned tg = og / nx;
            if (og + 1u == (tg + 1u) * nx) xb_add(&bar[XB_TOPGEN], 1u);
            else XB_SPIN(xb_ld(&bar[XB_TOPGEN]) == tg, bar);
            __builtin_amdgcn_fence(__ATOMIC_ACQUIRE, "agent");
            xb_add(&bar[XB_XGEN(b.x)], 1u);
            asm volatile("s_waitcnt vmcnt(0)" ::: "memory");
        } else {
            XB_SPIN(xb_ld(&bar[XB_XGEN(b.x)]) == gen, bar);
            __builtin_amdgcn_fence(__ATOMIC_ACQUIRE, "agent");
            asm volatile("s_waitcnt vmcnt(0)" ::: "memory");
        }
    }
    __syncthreads();
}

struct Args { const void* in[24]; float* out; unsigned char* ws; };
constexpr int XB_ST_OFF = 131072 + 512;
constexpr size_t WS_CTL = 896 * 1024, CTL_BYTES = 16384;
constexpr int PTR_STASH = 131072;
__device__ __forceinline__ const void* ldp(LAS unsigned char* L, int i) { int z = 0; asm volatile("" : "+v"(z)); const unsigned long long v = *(volatile LAS unsigned long long*)(L + PTR_STASH + 8 * i + z);
    const unsigned lo = __builtin_amdgcn_readfirstlane((unsigned)v), hi = __builtin_amdgcn_readfirstlane((unsigned)(v >> 32)); return (const void*)(((unsigned long long)hi << 32) | lo); }

__global__ void __launch_bounds__(NWAVES * 64, 2) fwd_kernel(Args args) {
    extern __shared__ __attribute__((aligned(16))) unsigned char lds[];
    cg::grid_group grid = cg::this_grid();
    LAS unsigned char* L = (LAS unsigned char*)lds;
    const int tid = threadIdx.x, lane = tid & 63, wave = __builtin_amdgcn_readfirstlane(tid >> 6);
    const int G = gridDim.x, bx = blockIdx.x, wave_s = wave;
    if (tid == 0) { LAS unsigned long long* P = (LAS unsigned long long*)(L + PTR_STASH);
#pragma unroll
        for (int i = 0; i < 24; ++i) P[i] = (unsigned long long)args.in[i];
        P[24] = (unsigned long long)args.out; P[25] = (unsigned long long)args.ws; }
    if (tid < 2) ((LAS unsigned*)(L + XB_ST_OFF))[tid] = 0u;
    __syncthreads();
    if (bx == 0) { unsigned* ctl0 = (unsigned*)(args.ws + WS_CTL); for (int i = tid; i < (int)(CTL_BYTES / 4); i += 512) ctl0[i] = 0u; }
#define GRID_BAR() do { XcdBarrier xb_; xb_.bar = (unsigned*)((unsigned char*)ldp(L, 25) + WS_CTL); xb_.x = xb_xcc_id(); xb_.st = (volatile LAS unsigned*)(L + XB_ST_OFF); xcd_barrier(xb_); } while (0)
    const int gw = bx * NWAVES + wave, NGW = G * NWAVES;
    const int gt = bx * 512 + tid, GT = G * 512;
    unsigned char* ws = args.ws;
    const float* x_in = (const float*)args.in[0];
    const float* c_in = (const float*)args.in[1];
    const int* pos_in = (const int*)args.in[2];
    const float* norm_g = (const float*)args.in[3];
    const float* w_ada = (const float*)args.in[4];
    const float* b_ada = (const float*)args.in[5];
    const float* w_in = (const float*)args.in[6];
    const float* w_out = (const float*)args.in[7];
    const float* a_re = (const float*)args.in[8];
    const float* a_im = (const float*)args.in[9];
    const float* b_re = (const float*)args.in[10];
    const float* b_im = (const float*)args.in[11];
    const float* c_re = (const float*)args.in[12];
    const float* c_im = (const float*)args.in[13];
    const float* ssm_d = (const float*)args.in[14];
    const float* log_step = (const float*)args.in[15];
    const float* w_glu = (const float*)args.in[16];
    const float* b_glu = (const float*)args.in[17];
    const float* lam_q1 = (const float*)args.in[18];
    const float* lam_k1 = (const float*)args.in[19];
    const float* lam_q2 = (const float*)args.in[20];
    const float* lam_k2 = (const float*)args.in[21];
    const float* sub_g = (const float*)args.in[22];
    const float* final_g = (const float*)args.in[23];
    float* MOD = (float*)(ws + WS_MOD);
    float* ROPEC = (float*)(ws + WS_ROPEC); float* ROPES = (float*)(ws + WS_ROPES);

    {
        LAS float* cact = (LAS float*)L; LAS float* part = cact + 8 * 2048;
        for (int i = tid; i < 8 * 2048; i += 512) { const float v = c_in[i]; cact[i] = v / (1.f + expf(-v)); }
        __syncthreads();
        for (int task = bx; task < DEPTH * 96; task += G) {
            const int l = task / 96, cb = task % 96;
            const float* w = w_ada + ((size_t)l * 2048 + wave * 256) * 6144 + cb * 64 + lane;
            float a0 = 0.f, a1 = 0.f, a2 = 0.f, a3 = 0.f, a4 = 0.f, a5 = 0.f, a6 = 0.f, a7 = 0.f;
            const LAS float* cw = cact + wave * 256;
#pragma unroll 32
            for (int kk = 0; kk < 256; ++kk) { const float wv = w[(size_t)kk * 6144];
                a0 += cw[kk] * wv; a1 += cw[2048 + kk] * wv; a2 += cw[4096 + kk] * wv; a3 += cw[6144 + kk] * wv;
                a4 += cw[8192 + kk] * wv; a5 += cw[10240 + kk] * wv; a6 += cw[12288 + kk] * wv; a7 += cw[14336 + kk] * wv; }
            LAS float* pw = part + wave * 512 + lane;
            pw[0] = a0; pw[64] = a1; pw[128] = a2; pw[192] = a3; pw[256] = a4; pw[320] = a5; pw[384] = a6; pw[448] = a7;
            __syncthreads();
            { const int b = tid >> 6; float s = b_ada[(size_t)l * 6144 + cb * 64 + lane];
#pragma unroll
              for (int w8 = 0; w8 < 8; ++w8) s += part[w8 * 512 + b * 64 + lane];
              MOD[((size_t)l * 8 + b) * 6144 + cb * 64 + lane] = s; }
            __syncthreads();
        }
    }
    {
        LAS float* ap = (LAS float*)L;
        LAS float* bb = ap + 17 * 64 * 2;
        LAS float* cc = bb + 64 * 16 * 2;
        LAS float* kt = cc + 16 * 64 * 2;
        for (int it = bx; it < DEPTH * 64; it += G) {
            const int l = it >> 6, g = it & 63, lg = it;
            const float step = expf(log_step[lg]);
            for (int idx = tid; idx < 17 * 64; idx += 512) { const int j = idx >> 6, n = idx & 63;
                const float re = a_re[lg * 64 + n], im = a_im[lg * 64 + n];
                const float mag = expf(re * step * (float)j); float s, c; sincos_d((double)im * (double)step * (double)j, s, c);
                ap[idx * 2] = mag * c; ap[idx * 2 + 1] = mag * s; }
            for (int idx = tid; idx < 64 * 16; idx += 512) { const int n = idx >> 4;
                const float re = a_re[lg * 64 + n], im = a_im[lg * 64 + n];
                const float xr = re * step; const float ex = expf(xr), em1 = expm1f(xr);
                float sy, cy, sh, chh; sincos_d((double)im * (double)step, sy, cy); sincos_d(0.5 * (double)im * (double)step, sh, chh);
                const float nr = em1 * cy - 2.f * sh * sh, ni = ex * sy;
                const float den = re * re + im * im, cr = (nr * re + ni * im) / den, ci = (ni * re - nr * im) / den;
                const float br = b_re[(size_t)lg * 1024 + idx], bi = b_im[(size_t)lg * 1024 + idx];
                bb[idx * 2] = cr * br - ci * bi; bb[idx * 2 + 1] = cr * bi + ci * br; }
            for (int idx = tid; idx < 1024; idx += 512) { cc[idx * 2] = c_re[(size_t)lg * 1024 + idx]; cc[idx * 2 + 1] = c_im[(size_t)lg * 1024 + idx]; }
            __syncthreads();
            for (int idx = tid; idx < 4096; idx += 512) { const int j = idx >> 8, p = (idx >> 4) & 15, q = idx & 15; float sum = 0.f;
                for (int n = 0; n < 64; ++n) { const float cr = cc[(p * 64 + n) * 2], ci = cc[(p * 64 + n) * 2 + 1], ar = ap[(j * 64 + n) * 2], ai = ap[(j * 64 + n) * 2 + 1];
                    const float tr = cr * ar - ci * ai, ti = cr * ai + ci * ar; sum += tr * bb[(n * 16 + q) * 2] - ti * bb[(n * 16 + q) * 2 + 1]; }
                if (j == 0 && p == q) sum += ssm_d[lg * 16 + p];
                kt[idx] = sum; }
            __syncthreads();
            bf16* W1 = (bf16*)(ws + WS_S5W + (size_t)l * S5W_LAYER) + (size_t)g * 128 * 256;
            bf16* W2 = (bf16*)(ws + WS_S5W + (size_t)l * S5W_LAYER + S5W2_OFF) + (size_t)g * 256 * 384;
            for (int i2 = tid; i2 < 256 * 192; i2 += 512) { const int row = i2 / 192, c0 = (i2 % 192) * 2, t = row >> 4, p = row & 15; float v[2];
#pragma unroll
                for (int e = 0; e < 2; ++e) { const int col = c0 + e;
                    if (col < 256) { const int tau = col >> 4, q = col & 15; v[e] = (tau <= t) ? kt[((t - tau) << 8) + (p << 4) + q] : 0.f; }
                    else { const int n = (col - 256) & 63; const float cr = cc[(p * 64 + n) * 2], ci = cc[(p * 64 + n) * 2 + 1], ar = ap[((t + 1) * 64 + n) * 2], ai = ap[((t + 1) * 64 + n) * 2 + 1];
                        v[e] = (col < 320) ? (cr * ar - ci * ai) : -(cr * ai + ci * ar); } }
                *(unsigned*)(W2 + (size_t)row * 384 + c0) = pk2(v[0], v[1]); }
            for (int i2 = tid; i2 < 128 * 128; i2 += 512) { const int row = i2 >> 7, c0 = (i2 & 127) * 2, n = row & 63; float v[2];
#pragma unroll
                for (int e = 0; e < 2; ++e) { const int col = c0 + e, tau = col >> 4, p = col & 15;
                    const float ar = ap[((15 - tau) * 64 + n) * 2], ai = ap[((15 - tau) * 64 + n) * 2 + 1], br = bb[(n * 16 + p) * 2], bi = bb[(n * 16 + p) * 2 + 1];
                    v[e] = (row < 64) ? (ar * br - ai * bi) : (ar * bi + ai * br); }
                *(unsigned*)(W1 + (size_t)row * 256 + c0) = pk2(v[0], v[1]); }
            __syncthreads();
        }
    }
    {
        for (int i = gt; i < NTOK * 32; i += GT) { const int j = i & 31; const int p = pos_in[i >> 5];
            const float inv = (float)exp2(-(double)j * (13.287712379549449 / 32.0));
            const float ang = (float)p * inv; float s, c; sincos_d((double)ang, s, c);
            ROPEC[i] = c; ROPES[i] = s; }
    }
    {
        LAS float* scr = (LAS float*)(L + wave * 16384);
        constexpr int I_IN = 32 * 192, I_OUT = 32 * 64, I_GLU = 16 * 64, I_L = I_IN + I_OUT + I_GLU;
        for (int it = gw; it < DEPTH * I_L; it += NGW) {
            const int l = it / I_L; int r = it % I_L;
            if (r < I_IN) { const int kb = r / 192, sb = r % 192; p0_transpose_item(w_in + (size_t)l * 2048 * 6144, 2048, 6144, (bf16*)(ws + WS_WIN) + (size_t)l * 6144 * 2048, win_srccol(sb * 32), sb * 32, kb * 64, scr, lane); continue; }
            r -= I_IN;
            if (r < I_OUT) { const int kb = r / 64, sb = r % 64; p0_transpose_item(w_out + (size_t)l * 2048 * 2048, 2048, 2048, (bf16*)(ws + WS_WOUT) + (size_t)l * 2048 * 2048, sb * 32, sb * 32, kb * 64, scr, lane); continue; }
            r -= I_OUT;
            { const int kb = r / 64, sb = r % 64; p0_transpose_item(w_glu + (size_t)l * 1024 * 2048, 1024, 2048, (bf16*)(ws + WS_WGLU) + (size_t)l * 2048 * 1024, wglu_srccol(sb * 32), sb * 32, kb * 64, scr, lane); }
        }
    }
    grid.sync();
    (void)xcd_barrier_post((unsigned*)((unsigned char*)ldp(L, 25) + WS_CTL), (volatile LAS unsigned*)(L + XB_ST_OFF));

#define PHASE_BEGIN() int zp_ = 0; asm volatile("" : "+v"(zp_)); int wv_ = wave_s, bxp_ = bx; asm volatile("" : "+s"(wv_), "+s"(bxp_)); const int lane = (int)__builtin_amdgcn_mbcnt_hi(~0u, __builtin_amdgcn_mbcnt_lo(~0u, (unsigned)zp_)), wave = wv_; const int tidp = wv_ * 64 + lane; const int gw = bxp_ * NWAVES + wave; unsigned char* ws = (unsigned char*)ldp(L, 25); (void)lane; (void)gw
#define WSP(T, off) ((T*)(ws + (off)))
#define LANE_ID(var) int var; { int z_ = 0; asm volatile("" : "+v"(z_)); var = (int)__builtin_amdgcn_mbcnt_hi(~0u, __builtin_amdgcn_mbcnt_lo(~0u, (unsigned)z_)); }
    {
        PHASE_BEGIN();
        const float* xin = (const float*)ldp(L, 0); const float* gl = (const float*)ldp(L, 3); const float* modl = WSP(const float, WS_MOD);
        bf16* XG = WSP(bf16, WS_H); float* ss0 = WSP(float, WS_SS);
        for (int m0 = gw * 2; m0 < NTOK; m0 += NGW * 2) {
            const int b = m0 >> 12;
            const GASP f32x4* xr = (const GASP f32x4*)(xin + (size_t)m0 * 2048) + lane;
            f32x4 v[2][8]; float s0 = 0.f, s1 = 0.f;
#pragma unroll
            for (int j = 0; j < 8; ++j) { v[0][j] = xr[64 * j]; v[1][j] = xr[512 + 64 * j]; }
#pragma unroll
            for (int j = 0; j < 8; ++j) { s0 += (v[0][j].x * v[0][j].x + v[0][j].y * v[0][j].y) + (v[0][j].z * v[0][j].z + v[0][j].w * v[0][j].w); s1 += (v[1][j].x * v[1][j].x + v[1][j].y * v[1][j].y) + (v[1][j].z * v[1][j].z + v[1][j].w * v[1][j].w); }
            s0 = wave_sum(s0, lane); s1 = wave_sum(s1, lane);
            if (lane == 0) { ((GASP float*)ss0)[m0] = s0; ((GASP float*)ss0)[m0 + 1] = s1; }
#pragma unroll
            for (int j = 0; j < 8; ++j) { const int k = 256 * j + 4 * lane;
                const f32x4 gm = *(const GASP f32x4*)(gl + k) * (*(const GASP f32x4*)(modl + (size_t)b * 6144 + 2048 + k) + 1.f);
                const f32x4 o0 = v[0][j] * gm, o1 = v[1][j] * gm;
                v2u w0, w1; w0.x = pk2(o0.x, o0.y); w0.y = pk2(o0.z, o0.w); w1.x = pk2(o1.x, o1.y); w1.y = pk2(o1.z, o1.w);
                *(GASP v2u*)(XG + (size_t)m0 * 2048 + k) = w0; *(GASP v2u*)(XG + (size_t)(m0 + 1) * 2048 + k) = w1; }
        }
        LAS float* sh = (LAS float*)L;
        for (int ll = 0; ll < DEPTH; ++ll) {
            __syncthreads();
            for (int i = tidp; i < 8 * 512; i += 512) { const int bb = i >> 9, k4 = (i & 511) * 4; *(LAS f32x4*)(sh + bb * 2048 + k4) = *(const GASP f32x4*)(modl + ((size_t)ll * 8 + bb) * 6144 + k4); }
            __syncthreads();
            const bf16* WT = WSP(const bf16, WS_WIN) + (size_t)ll * 6144 * 2048; float* bias = WSP(float, WS_BIAS) + (size_t)ll * 8 * 6144;
            for (int r = gw; r < INW; r += NGW) {
                float a8[8];
#pragma unroll
                for (int bb = 0; bb < 8; ++bb) a8[bb] = 0.f;
#pragma unroll 1
                for (int j = 0; j < 4; ++j) { const int k = j * 512 + lane * 8; const v4u wv = *(const GASP v4u*)(WT + (size_t)r * 2048 + k);
                    const float w0 = bflo(wv.x), w1 = bfhi(wv.x), w2 = bflo(wv.y), w3 = bfhi(wv.y), w4 = bflo(wv.z), w5 = bfhi(wv.z), w6 = bflo(wv.w), w7 = bfhi(wv.w);
#pragma unroll
                    for (int bb = 0; bb < 8; ++bb) { const f32x4 sa = *(const LAS f32x4*)(sh + bb * 2048 + k), sb = *(const LAS f32x4*)(sh + bb * 2048 + k + 4);
                        a8[bb] += (sa.x * w0 + sa.y * w1) + (sa.z * w2 + sa.w * w3) + (sb.x * w4 + sb.y * w5) + (sb.z * w6 + sb.w * w7); } }
#pragma unroll
                for (int bb = 0; bb < 8; ++bb) { const float s = wave_sum(a8[bb], lane); if (lane == 0) ((GASP float*)bias)[(size_t)bb * 6144 + r] = s; }
            }
        }
    }
    GRID_BAR();
    for (int l = 0; l < DEPTH; ++l) {
        {
            PHASE_BEGIN();
            pg8::Gemm g{WSP(const bf16, WS_H), WSP(const bf16, WS_WIN) + (size_t)l * 6144 * 2048, NTOK, INW, 2048, 2048, 2048, 1 << 30, 0};
            pg8::StaticOrder S; S.init(NTOK, INW, G, bx);
            pg8::EpiInProj Ep{ws, l};
            pg8::gemm_phase<pg8::EpiInProj, pg8::StaticOrder, true, true>(L, g, S, Ep, tidp);
        }
        GRID_BAR();
        {
            PHASE_BEGIN();
            pg8::Gemm g{WSP(const bf16, WS_A2), WSP(const bf16, WS_S5W + (size_t)l * S5W_LAYER), 64 * 2048, 256, 256, pg8::A2_LD, 256, 8, 128};
            pg8::StaticOrder S; S.init(64 * 2048, 256, G, bx);
            pg8::EpiS5P1 Ep{ws};
            pg8::gemm_phase<pg8::EpiS5P1, pg8::StaticOrder, true, true>(L, g, S, Ep, tidp);
        }
        asm volatile("s_waitcnt vmcnt(0) lgkmcnt(0)" ::: "memory"); __syncthreads();
        {
            PHASE_BEGIN();
            LAS float* tot = (LAS float*)L;
            { float* ssz = WSP(float, WS_SS) + ((l + 1) & 1) * 32768; for (int i = bx * 512 + tidp; i < 32768; i += G * 512) ((GASP float*)ssz)[i] = 0.f; }
            const float* log_step = (const float*)ldp(L, 15); const float* a_re = (const float*)ldp(L, 8); const float* a_im = (const float*)ldp(L, 9);
            const float* E = WSP(const float, WS_H); bf16* A2 = WSP(bf16, WS_A2);
            pg8::StaticOrder SO; SO.init(64 * 2048, 256, G, bx);
            pg8::Unit su;
            for (int ui = 0; SO.next(ui, su); ++ui) {
                const int b = su.pm & 7, g = su.pm >> 3, n = lane, seg = wave, lg = l * 64 + g;
                const float step = expf(log_step[lg]); const float re = a_re[lg * 64 + n], im = a_im[lg * 64 + n];
                float aLr, aLi; { const float mag = expf(re * step * 16.f); float s, c; sincos_d((double)im * (double)step * 16.0, s, c); aLr = mag * c; aLi = mag * s; }
                const GASP float* Ep = (const GASP float*)(E + ((size_t)(g * 2048 + b * 256 + seg * 32)) * 128 + n);
                float hr[32], hi[32]; float sr = 0.f, si = 0.f;
#pragma unroll
                for (int j = 0; j < 32; ++j) { const float er = Ep[(size_t)j * 128], ei = Ep[(size_t)j * 128 + 64];
                    const float tr = aLr * sr - aLi * si + er, ti = aLr * si + aLi * sr + ei; sr = tr; si = ti; hr[j] = sr; hi[j] = si; }
                tot[(seg * 64 + n) * 2] = sr; tot[(seg * 64 + n) * 2 + 1] = si;
                float pr = aLr, pi = aLi;
#pragma unroll
                for (int q = 0; q < 5; ++q) { const float tr = pr * pr - pi * pi, ti = 2.f * pr * pi; pr = tr; pi = ti; }
                __syncthreads();
                float cr = 0.f, ci = 0.f;
                for (int s2 = 0; s2 < seg; ++s2) { const float tr = pr * cr - pi * ci + tot[(s2 * 64 + n) * 2], ti = pr * ci + pi * cr + tot[(s2 * 64 + n) * 2 + 1]; cr = tr; ci = ti; }
                GASP bf16* Ap = (GASP bf16*)(A2 + ((size_t)(g * 2048 + b * 256 + seg * 32)) * pg8::A2_LD + 256 + n);
#pragma unroll
                for (int j = 0; j < 32; ++j) { const float vr = cr + (j ? hr[j - 1] : 0.f), vi = ci + (j ? hi[j - 1] : 0.f);
                    Ap[(size_t)j * pg8::A2_LD] = (bf16)f2bf(vr); Ap[(size_t)j * pg8::A2_LD + 64] = (bf16)f2bf(vi);
                    const float tr = aLr * cr - aLi * ci, ti = aLr * ci + aLi * cr; cr = tr; ci = ti; }
                __syncthreads();
            }
        }
        asm volatile("s_waitcnt vmcnt(0) lgkmcnt(0)" ::: "memory"); __syncthreads();
        {
            PHASE_BEGIN();
            pg8::Gemm g{WSP(const bf16, WS_A2), WSP(const bf16, WS_S5W + (size_t)l * S5W_LAYER + S5W2_OFF), 64 * 2048, 256, 384, pg8::A2_LD, 384, 8, 256};
            pg8::StaticOrder S; S.init(64 * 2048, 256, G, bx);
            pg8::EpiS5P2 Ep{ws};
            pg8::gemm_phase<pg8::EpiS5P2, pg8::StaticOrder, true, true>(L, g, S, Ep, tidp);
        }
        GRID_BAR();
        {
            PHASE_BEGIN();
            pg8::Gemm g{WSP(const bf16, WS_E), WSP(const bf16, WS_WGLU) + (size_t)l * 2048 * 1024, NTOK, 2048, 1024, 1024, 1024, 1 << 30, 0};
            pg8::StaticOrder S; S.init(NTOK, 2048, G, bx);
            pg8::EpiGlu Ep{ws, (const float*)ldp(L, 17) + (size_t)l * 2048};
            pg8::gemm_phase<pg8::EpiGlu, pg8::StaticOrder, true, true>(L, g, S, Ep, tidp);
        }
        {
            PHASE_BEGIN();
            const int vcu = (G % 8 == 0) ? (bx % 8) * (G / 8) + bx / 8 : bx;
            for (int grp = vcu; grp < 256; grp += G) {
                const int b = grp >> 5, h = (grp >> 2) & 7, s4 = grp & 3;
                for (int cm = 0; cm < 4; ++cm) { const int mp = cm >> 1, vh = cm & 1;
                    for (int qi = 0; qi < 4; ++qi) {
                        const int qb = (qi == 0) ? 15 - s4 : (qi == 1) ? 8 + s4 : (qi == 2) ? 7 - s4 : s4;
                        int t2 = tidp; asm volatile("" : "+v"(t2));
                        unsigned char* w2 = ws; asm volatile("" : "+s"(w2));
                        attn_body::attn_unit<8>(b, (h * 2 + mp) * 64, h * 128 + vh * 64, qb, (const attn_body::bf16*)(w2 + WS_Q), (const attn_body::bf16*)(w2 + WS_K), (const attn_body::bf16*)(w2 + WS_V),
                                                (attn_body::bf16*)(w2 + WS_H) + (mp ? (size_t)NTOK * 1024 : 0), (char*)lds, t2); } }
                for (int qi = 0; qi < 4; ++qi) {
                    const int qb = (qi == 0) ? 15 - s4 : (qi == 1) ? 8 + s4 : (qi == 2) ? 7 - s4 : s4;
                    {
                        asm volatile("s_waitcnt vmcnt(0)" ::: "memory");
                        int ln = tidp & 63; asm volatile("" : "+v"(ln));
                        unsigned char* w2 = ws; asm volatile("" : "+s"(w2));
                        const float lambda_init = 0.8f - 0.6f * expf(-0.3f * (float)l);
                        const float* lq1 = (const float*)ldp(L, 18); const float* lk1 = (const float*)ldp(L, 19); const float* lq2 = (const float*)ldp(L, 20); const float* lk2 = (const float*)ldp(L, 21);
                        const float d1 = wave_sum(lq1[l * 64 + ln] * lk1[l * 64 + ln], ln), d2 = wave_sum(lq2[l * 64 + ln] * lk2[l * 64 + ln], ln);
                        const float lam = expf(d1) - expf(d2) + lambda_init;
                        const int c8 = (ln & 15) * 8, sub = ln >> 4;
                        const float* sg = (const float*)ldp(L, 22) + (size_t)l * 128 + c8;
                        const f32x4 sg0 = *(const GASP f32x4*)sg * (1.f - lambda_init), sg1 = *(const GASP f32x4*)(sg + 4) * (1.f - lambda_init);
                        const size_t r0 = (size_t)b * SEQ + qb * 256 + wave * 32 + sub;
                        const bf16* O1 = (const bf16*)(w2 + WS_H); const bf16* O2 = O1 + (size_t)NTOK * 1024; const bf16* ZA = (const bf16*)(w2 + WS_ZA); bf16* YCAT = (bf16*)(w2 + WS_A2);
                        v4u pp[8], qq[8], zz[8];
#pragma unroll
                        for (int it = 0; it < 8; ++it) { const size_t off = (r0 + it * 4) * 1024 + h * 128 + c8;
                            pp[it] = *(const GASP v4u*)(O1 + off); qq[it] = *(const GASP v4u*)(O2 + off);
                            zz[it] = *(const GASP v4u*)(ZA + off); }
#pragma unroll
                        for (int it = 0; it < 8; ++it) { const size_t row = r0 + it * 4; const v4u p = pp[it], q = qq[it], z = zz[it];
                            float d[8]; float ss = 0.f;
#pragma unroll
                            for (int e = 0; e < 4; ++e) { d[2 * e] = bflo(p[e]) - lam * bflo(q[e]); d[2 * e + 1] = bfhi(p[e]) - lam * bfhi(q[e]); ss += d[2 * e] * d[2 * e] + d[2 * e + 1] * d[2 * e + 1]; }
                            ss += lane_xor(ss, ln, 1); ss += lane_xor(ss, ln, 2); ss += lane_xor(ss, ln, 4); ss += lane_xor(ss, ln, 8);
                            const float r = 1.0f / sqrtf(ss * (1.f / 128.f) + 1e-6f);
                            v4u o;
                            o[0] = pk2(d[0] * r * sg0[0] * bflo(z[0]), d[1] * r * sg0[1] * bfhi(z[0])); o[1] = pk2(d[2] * r * sg0[2] * bflo(z[1]), d[3] * r * sg0[3] * bfhi(z[1]));
                            o[2] = pk2(d[4] * r * sg1[0] * bflo(z[2]), d[5] * r * sg1[1] * bfhi(z[2])); o[3] = pk2(d[6] * r * sg1[2] * bflo(z[3]), d[7] * r * sg1[3] * bfhi(z[3]));
                            *(GASP v4u*)(YCAT + row * 2048 + 1024 + h * 128 + c8) = o; }
                    }
                }
            }
        }
        GRID_BAR();
        {
            PHASE_BEGIN();
            pg8::Gemm g{WSP(const bf16, WS_A2), WSP(const bf16, WS_WOUT) + (size_t)l * 2048 * 2048, NTOK, 2048, 2048, 2048, 2048, 1 << 30, 0};
            pg8::StaticOrder S; S.init(NTOK, 2048, G, bx);
            pg8::EpiOut Ep{(l == 0) ? (const float*)ldp(L, 0) : (const float*)ldp(L, 24), (float*)ldp(L, 24), ws, (const float*)ldp(L, 3) + (size_t)(l < 3 ? l + 1 : 0) * 2048, l};
            pg8::gemm_phase<pg8::EpiOut, pg8::StaticOrder, true, true>(L, g, S, Ep, tidp);
        }
        GRID_BAR();
    }
    {
        PHASE_BEGIN();
        float* xres = (float*)ldp(L, 24); const float* final_g = (const float*)ldp(L, 23); (void)ws;
        for (int m = gw; m < NTOK; m += NGW) {
            GASP f32x4* xr = (GASP f32x4*)(xres + (size_t)m * 2048) + lane;
            f32x4 v[8]; float s = 0.f;
#pragma unroll
            for (int j = 0; j < 8; ++j) { v[j] = xr[64 * j]; s += (v[j].x * v[j].x + v[j].y * v[j].y) + (v[j].z * v[j].z + v[j].w * v[j].w); }
            const float r = 1.0f / sqrtf(wave_sum(s, lane) * (1.f / 2048.f) + 1e-6f);
#pragma unroll
            for (int j = 0; j < 8; ++j) { const f32x4 gg = *(const GASP f32x4*)(final_g + 256 * j + 4 * lane); xr[64 * j] = (v[j] * r) * gg; }
        }
    }
}

extern "C" void kernel_launch(void* const* d_in, const int* in_sizes, int n_in, void* d_out, int out_size, void* d_ws, size_t ws_size, hipStream_t stream) {
    static int grid = 0;
    if (grid == 0) {
        if (n_in != 24 || out_size != NTOK * DMODEL || ws_size < WS_END) { fprintf(stderr, "kernel_launch: unexpected shapes (n_in %d out %d ws %zu); nothing launched\n", n_in, out_size, ws_size); grid = -1; return; }
        int dev = 0, cus = 0, per_cu = 0;
        if (hipGetDevice(&dev) != hipSuccess || hipDeviceGetAttribute(&cus, hipDeviceAttributeMultiprocessorCount, dev) != hipSuccess) { grid = -1; return; }
        if (hipFuncSetAttribute((const void*)fwd_kernel, hipFuncAttributeMaxDynamicSharedMemorySize, LDS_BYTES) != hipSuccess) { fprintf(stderr, "kernel_launch: hipFuncSetAttribute failed\n"); grid = -1; return; }
        if (hipOccupancyMaxActiveBlocksPerMultiprocessor(&per_cu, (const void*)fwd_kernel, NWAVES * 64, LDS_BYTES) != hipSuccess || per_cu < 1) { fprintf(stderr, "kernel_launch: occupancy query says %d blocks per CU\n", per_cu); per_cu = 1; }
        (void)hipGetLastError();
        grid = cus;
    }
    if (grid < 0) return;
    Args a{};
    for (int i = 0; i < 24; ++i) a.in[i] = d_in[i];
    a.out = (float*)d_out; a.ws = (unsigned char*)d_ws;
    void* kargs[] = {&a};
    const hipError_t e = hipLaunchCooperativeKernel((const void*)fwd_kernel, dim3(grid), dim3(NWAVES * 64), kargs, LDS_BYTES, stream);
    if (e != hipSuccess) fprintf(stderr, "kernel_launch: cooperative launch failed: %s (grid %d)\n", hipGetErrorString(e), grid);
}
```

```cpp
#include <hip/hip_runtime.h>
#include <hip/hip_cooperative_groups.h>
#include <cstdio>
#include <cstdint>
namespace cg = cooperative_groups;
#define GASP __attribute__((address_space(1)))
constexpr int BATCH = 8, SEQ = 4096, DMODEL = 2048, NTOK = BATCH * SEQ, DEPTH = 4, INW = 6144;
constexpr int NWAVES = 8;
constexpr size_t MiB = 1u << 20;
constexpr size_t WS_MOD = 0;
constexpr size_t WS_ROPEC = 1 * MiB, WS_ROPES = 5 * MiB;
constexpr size_t WS_S5W = 10 * MiB, S5W_LAYER = 16 * MiB, S5W2_OFF = 4 * MiB;
constexpr size_t WS_WIN = 74 * MiB, WS_WOUT = 170 * MiB, WS_WGLU = 202 * MiB;
constexpr size_t WS_H = 218 * MiB;
constexpr size_t WS_A2 = 346 * MiB;
constexpr size_t WS_E = 474 * MiB;
constexpr size_t WS_ZS = 538 * MiB, WS_Q = 602 * MiB, WS_K = 666 * MiB, WS_V = 730 * MiB, WS_ZA = 794 * MiB, WS_BIAS = 858 * MiB, WS_END = 860 * MiB;
constexpr size_t WS_SS = 9 * MiB;
constexpr int LDS_BYTES = 135168;

namespace pg8 {
#define PG8_LAS __attribute__((address_space(3)))
typedef unsigned short bf16_t;
typedef short bf16x8 __attribute__((ext_vector_type(8)));
typedef float f32x4 __attribute__((ext_vector_type(4)));
typedef unsigned u32x4 __attribute__((ext_vector_type(4)));
constexpr int BM = 256, BK = 64, HALF = 128, HTB = HALF * BK * 2  , STAGE_BYTES = 8 * HTB, NXCD = 8, WGM = 8;

__host__ __device__ __forceinline__ int lds_byte(int r, int c) { const int st = (r >> 4) * 2 + (c >> 5), rr = r & 15, cc = c & 31, ob = rr * 64 + cc * 2; return st * 1024 + (ob ^ (((ob >> 9) & 1) << 5)); }
__host__ __device__ __forceinline__ void stage_rc(int b, int& R, int& C) { const int st = b / 1024, sb = b % 1024, swz = sb ^ (((sb >> 9) & 1) << 5); R = (st >> 1) * 16 + swz / 64; C = (st & 1) * 32 + (swz % 64) / 2; }
__host__ __device__ __forceinline__ int perm32(int rho) { const int n = rho >> 4, i = rho & 15; return 8 * (i >> 2) + 4 * n + (i & 3); }

struct Unit { int pm, pn; };
struct Gemm { const bf16_t* A; const bf16_t* Bt; int M, N, K, lda, ldb, grp_tiles, grp_brows; };

struct StaticOrder {
    int nM, nN, nwg, G, c;
    __host__ __device__ void init(int M, int N, int G_, int c_) { nM = M / BM; nN = N / BM; nwg = nM * nN; G = G_; c = c_; }
    __host__ __device__ bool next(int i, Unit& u) const {
        const long L = (long)i * G + c; if (L >= nwg) return false;
        int wgid = (int)L; { const int q = nwg / NXCD, r = nwg % NXCD, xcd = wgid % NXCD, off = wgid / NXCD; wgid = (xcd < r ? xcd * (q + 1) : r * (q + 1) + (xcd - r) * q) + off; }
        const int nig = WGM * nN, gid = wgid / nig, fm = gid * WGM, gsz = (nM - fm) < WGM ? (nM - fm) : WGM;
        u.pm = fm + ((wgid % nig) % gsz); u.pn = (wgid % nig) / gsz; return true;
    }
    __device__ __forceinline__ void a_ready(const Unit&) const {}
    __device__ __forceinline__ void done(const Unit&) const {}
};


__device__ __forceinline__ unsigned cvt_pk_bf16(float lo, float hi) { unsigned r; asm volatile("v_cvt_pk_bf16_f32 %0, %1, %2" : "=v"(r) : "v"(lo), "v"(hi)); return r; }
__device__ __forceinline__ u32x4 pack8(f32x4 a, f32x4 b) { u32x4 w; w.x = cvt_pk_bf16(a[0], a[1]); w.y = cvt_pk_bf16(a[2], a[3]); w.z = cvt_pk_bf16(b[0], b[1]); w.w = cvt_pk_bf16(b[2], b[3]); return w; }
__device__ __forceinline__ void unpack8(u32x4 w, f32x4& a, f32x4& b) {
    a[0] = __uint_as_float(w.x << 16); a[1] = __uint_as_float(w.x & 0xffff0000u); a[2] = __uint_as_float(w.y << 16); a[3] = __uint_as_float(w.y & 0xffff0000u);
    b[0] = __uint_as_float(w.z << 16); b[1] = __uint_as_float(w.z & 0xffff0000u); b[2] = __uint_as_float(w.w << 16); b[3] = __uint_as_float(w.w & 0xffff0000u); }
__device__ __forceinline__ float sigmoid_f(float x) { return __builtin_amdgcn_rcpf(1.f + __builtin_amdgcn_exp2f(-1.4426950408889634f * x)); }
__device__ __forceinline__ float silu_f(float x) { return x * sigmoid_f(x); }
__device__ __forceinline__ float gelu_tanh_f(float x) { return x * sigmoid_f(1.5957691216057308f * (x + 0.044715f * x * x * x)); }
__device__ __forceinline__ f32x4 silu4(f32x4 v) { return (f32x4){silu_f(v[0]), silu_f(v[1]), silu_f(v[2]), silu_f(v[3])}; }
__device__ __forceinline__ f32x4 gelu4(f32x4 v) { return (f32x4){gelu_tanh_f(v[0]), gelu_tanh_f(v[1]), gelu_tanh_f(v[2]), gelu_tanh_f(v[3])}; }
__device__ __forceinline__ f32x4 sigm4(f32x4 v) { return (f32x4){sigmoid_f(v[0]), sigmoid_f(v[1]), sigmoid_f(v[2]), sigmoid_f(v[3])}; }

constexpr float QK_C2 = 0.125f * 1.4426950408889634f;
constexpr int A2_LD = 384;

struct EpiInProj {
    static constexpr bool PERM = true, AFTER_DRAIN = false;
    unsigned char* ws; int l;
    __device__ __forceinline__ void operator()(const f32x4 (&acc_)[2][2][4][2], const Unit& u, int wr, int wc, int fr, int fq) const {
        unsigned char* w = ws; asm volatile("" : "+s"(w));
        f32x4 acc[2][2][4][2];
        { const GASP float* ssp = (const GASP float*)(w + WS_SS) + (l & 1) * 32768 + u.pm * BM + wr * 64 + fr; const float* bp = (const float*)(w + WS_BIAS) + ((size_t)l * 8 + (u.pm >> 4)) * 6144 + u.pn * BM + 32 * wc + 8 * fq;
          f32x4 bs[2][2];
_Pragma("unroll") for (int bj = 0; bj < 2; ++bj) _Pragma("unroll") for (int n = 0; n < 2; ++n) bs[bj][n] = *(const GASP f32x4*)(bp + bj * HALF + 4 * n);
          float sv[2][4];
_Pragma("unroll") for (int ai = 0; ai < 2; ++ai) _Pragma("unroll") for (int m = 0; m < 4; ++m) sv[ai][m] = ssp[ai * HALF + m * 16];
          asm volatile("" : "+v"(sv[0][0]), "+v"(sv[0][1]), "+v"(sv[0][2]), "+v"(sv[0][3]), "+v"(sv[1][0]), "+v"(sv[1][1]), "+v"(sv[1][2]), "+v"(sv[1][3]));
_Pragma("unroll") for (int ai = 0; ai < 2; ++ai) _Pragma("unroll") for (int m = 0; m < 4; ++m) { const float rr = __builtin_amdgcn_rsqf(sv[ai][m] * (1.f / 2048.f) + 1e-6f);
_Pragma("unroll") for (int bj = 0; bj < 2; ++bj) _Pragma("unroll") for (int n = 0; n < 2; ++n) acc[ai][bj][m][n] = acc_[ai][bj][m][n] * rr + bs[bj][n]; } }
        bf16_t* A2 = (bf16_t*)(w + WS_A2); const float* ropec = (const float*)(w + WS_ROPEC); const float* ropes = (const float*)(w + WS_ROPES);
        const int seg = u.pn >> 2, colt = (u.pn & 3) * 256, row0 = u.pm * BM + wr * 64 + fr;
        if (seg == 2 || seg == 3) {
            bf16_t* O = (bf16_t*)(w + ((seg == 2) ? WS_Q : WS_K)); const float sc = (seg == 2) ? QK_C2 : 1.f;
#pragma unroll
            for (int ai = 0; ai < 2; ++ai) {
                f32x4 tc0[4], tc1[4], ts0[4], ts1[4];
#pragma unroll
                for (int m = 0; m < 4; ++m) { const size_t tr = (size_t)(row0 + ai * HALF + m * 16) * 32 + 8 * fq;
                    tc0[m] = *(const GASP f32x4*)(ropec + tr); tc1[m] = *(const GASP f32x4*)(ropec + tr + 4); ts0[m] = *(const GASP f32x4*)(ropes + tr); ts1[m] = *(const GASP f32x4*)(ropes + tr + 4); }
#pragma unroll
                for (int m = 0; m < 4; ++m) { const int row = row0 + ai * HALF + m * 16;
                    const f32x4 c0 = tc0[m], c1 = tc1[m], s0 = ts0[m], s1 = ts1[m];
                    const f32x4 a0 = acc[ai][0][m][0], a1 = acc[ai][0][m][1], b0 = acc[ai][1][m][0], b1 = acc[ai][1][m][1];
                    const f32x4 o10 = (a0 * c0 - b0 * s0) * sc, o11 = (a1 * c1 - b1 * s1) * sc, o20 = (b0 * c0 + a0 * s0) * sc, o21 = (b1 * c1 + a1 * s1) * sc;
                    bf16_t* p = O + (size_t)row * 1024 + colt + 64 * wc + 8 * fq;
                    *(GASP u32x4*)p = pack8(o10, o11); *(GASP u32x4*)(p + 32) = pack8(o20, o21); } }
        } else if (seg == 0) {
#pragma unroll
            for (int ai = 0; ai < 2; ++ai)
#pragma unroll
                for (int m = 0; m < 4; ++m) { const int row = row0 + ai * HALF + m * 16;
#pragma unroll
                    for (int bj = 0; bj < 2; ++bj) { const int col = colt + bj * HALF + 32 * wc + 8 * fq, g = col >> 4, p0 = col & 15;
                        *(GASP u32x4*)(A2 + ((size_t)(g * 2048 + (row >> 4)) * A2_LD + (row & 15) * 16 + p0)) = pack8(acc[ai][bj][m][0], acc[ai][bj][m][1]); } }
        } else {
            bf16_t* O = (bf16_t*)(w + ((seg == 1) ? WS_ZS : (seg == 4) ? WS_V : WS_ZA)); const bool act = (seg != 4);
#pragma unroll
            for (int ai = 0; ai < 2; ++ai)
#pragma unroll
                for (int m = 0; m < 4; ++m) { const int row = row0 + ai * HALF + m * 16;
#pragma unroll
                    for (int bj = 0; bj < 2; ++bj) { f32x4 v0 = acc[ai][bj][m][0], v1 = acc[ai][bj][m][1];
                        if (act) { v0 = silu4(v0); v1 = silu4(v1); }
                        *(GASP u32x4*)(O + (size_t)row * 1024 + colt + bj * HALF + 32 * wc + 8 * fq) = pack8(v0, v1); } }
        }
    }
};
struct EpiS5P1 {
    static constexpr bool PERM = true, AFTER_DRAIN = false;
    unsigned char* ws;
    __device__ __forceinline__ void operator()(const f32x4 (&acc)[2][2][4][2], const Unit& u, int wr, int wc, int fr, int fq) const {
        unsigned char* w = ws; asm volatile("" : "+s"(w)); float* E = (float*)(w + WS_H);
        const int row0 = u.pm * BM + wr * 64 + fr;
#pragma unroll
        for (int ai = 0; ai < 2; ++ai)
#pragma unroll
            for (int m = 0; m < 4; ++m) { float* p = E + (size_t)(row0 + ai * HALF + m * 16) * 128 + 32 * wc + 8 * fq;
                *(GASP f32x4*)p = acc[ai][0][m][0]; *(GASP f32x4*)(p + 4) = acc[ai][0][m][1]; }
    }
};
struct EpiS5P2 {
    static constexpr bool PERM = true, AFTER_DRAIN = false;
    unsigned char* ws;
    __device__ __forceinline__ void operator()(const f32x4 (&acc)[2][2][4][2], const Unit& u, int wr, int wc, int fr, int fq) const {
        unsigned char* w = ws; asm volatile("" : "+s"(w)); bf16_t* YG = (bf16_t*)(w + WS_E);
        const int g = u.pm >> 3, crow0 = (u.pm & 7) * BM + wr * 64 + fr;
#pragma unroll
        for (int ai = 0; ai < 2; ++ai)
#pragma unroll
            for (int m = 0; m < 4; ++m) { const int crow = crow0 + ai * HALF + m * 16;
#pragma unroll
                for (int bj = 0; bj < 2; ++bj) { const int col = bj * HALF + 32 * wc + 8 * fq, t = col >> 4, p0 = col & 15;
                    *(GASP u32x4*)(YG + (size_t)(crow * 16 + t) * 1024 + g * 16 + p0) = pack8(gelu4(acc[ai][bj][m][0]), gelu4(acc[ai][bj][m][1])); } }
    }
};
struct EpiGlu {
    static constexpr bool PERM = true, AFTER_DRAIN = false;
    unsigned char* ws; const float* bias;
    __device__ __forceinline__ void operator()(const f32x4 (&acc)[2][2][4][2], const Unit& u, int wr, int wc, int fr, int fq) const {
        unsigned char* w = ws; asm volatile("" : "+s"(w)); bf16_t* YCAT = (bf16_t*)(w + WS_A2); const bf16_t* ZS = (const bf16_t*)(w + WS_ZS);
        const int row0 = u.pm * BM + wr * 64 + fr, col = u.pn * 128 + 32 * wc + 8 * fq;
        const f32x4 ba0 = *(const GASP f32x4*)(bias + col), ba1 = *(const GASP f32x4*)(bias + col + 4), bb0 = *(const GASP f32x4*)(bias + 1024 + col), bb1 = *(const GASP f32x4*)(bias + 1024 + col + 4);
        u32x4 zr[2][4];
#pragma unroll
        for (int ai = 0; ai < 2; ++ai)
#pragma unroll
            for (int m = 0; m < 4; ++m) zr[ai][m] = *(const GASP u32x4*)(ZS + (size_t)(row0 + ai * HALF + m * 16) * 1024 + col);
#pragma unroll
        for (int ai = 0; ai < 2; ++ai)
#pragma unroll
            for (int m = 0; m < 4; ++m) { const int row = row0 + ai * HALF + m * 16;
                f32x4 z0, z1; unpack8(zr[ai][m], z0, z1);
                const f32x4 o0 = (acc[ai][0][m][0] + ba0) * sigm4(acc[ai][1][m][0] + bb0) * z0, o1 = (acc[ai][0][m][1] + ba1) * sigm4(acc[ai][1][m][1] + bb1) * z1;
                *(GASP u32x4*)(YCAT + (size_t)row * 2048 + col) = pack8(o0, o1); }
    }
};
struct EpiOut {
    static constexpr bool PERM = true, AFTER_DRAIN = false;
    const float* xin; float* xout; unsigned char* ws; const float* ng_next; int l;
    __device__ __forceinline__ void operator()(const f32x4 (&acc)[2][2][4][2], const Unit& u, int wr, int wc, int fr, int fq) const {
        unsigned char* w = ws; asm volatile("" : "+s"(w));
        const float* modl = (const float*)(w + WS_MOD) + (size_t)l * 8 * 6144; const float* modn = modl + 8 * 6144;
        bf16_t* XG = (bf16_t*)(w + WS_H);
        const int row0 = u.pm * BM + wr * 64 + fr, b = u.pm >> 4; const bool nxt = l < 3;
        float part[2][4];
#pragma unroll
        for (int ai = 0; ai < 2; ++ai)
#pragma unroll
            for (int m = 0; m < 4; ++m) part[ai][m] = 0.f;
#pragma unroll
        for (int bj = 0; bj < 2; ++bj) { const int col = u.pn * BM + bj * HALF + 32 * wc + 8 * fq;
            f32x4 g0 = *(const GASP f32x4*)(modl + (size_t)b * 6144 + 4096 + col), g1 = *(const GASP f32x4*)(modl + (size_t)b * 6144 + 4096 + col + 4);
            f32x4 gn0 = g0, gn1 = g1, gs0 = g0, gs1 = g1;
            if (nxt) { gn0 = *(const GASP f32x4*)(ng_next + col); gn1 = *(const GASP f32x4*)(ng_next + col + 4); gs0 = *(const GASP f32x4*)(modn + (size_t)b * 6144 + 2048 + col); gs1 = *(const GASP f32x4*)(modn + (size_t)b * 6144 + 2048 + col + 4); }
            f32x4 gm0 = g0, gm1 = g1;
#pragma unroll
            for (int ai = 0; ai < 2; ++ai) {
                f32x4 xa[4], xb[4];
#pragma unroll
                for (int m = 0; m < 4; ++m) { const size_t off = (size_t)(row0 + ai * HALF + m * 16) * 2048 + col; xa[m] = *(const GASP f32x4*)(xin + off); xb[m] = *(const GASP f32x4*)(xin + off + 4); }
                if (ai == 0) { asm volatile("" : "+v"(g0), "+v"(g1), "+v"(gn0), "+v"(gn1), "+v"(gs0), "+v"(gs1));
                    if (nxt) { gm0 = gn0 * (gs0 + 1.f); gm1 = gn1 * (gs1 + 1.f); } else { gm0 = g0; gm1 = g1; } }
#pragma unroll
                for (int m = 0; m < 4; ++m) { const size_t off = (size_t)(row0 + ai * HALF + m * 16) * 2048 + col;
                    const f32x4 x0 = xa[m], x1 = xb[m];
                    const f32x4 y0 = x0 + g0 * acc[ai][bj][m][0], y1 = x1 + g1 * acc[ai][bj][m][1];
                    *(GASP f32x4*)(xout + off) = y0; *(GASP f32x4*)(xout + off + 4) = y1;
                    if (nxt) { part[ai][m] += (y0[0] * y0[0] + y0[1] * y0[1]) + (y0[2] * y0[2] + y0[3] * y0[3]) + (y1[0] * y1[0] + y1[1] * y1[1]) + (y1[2] * y1[2] + y1[3] * y1[3]);
                        *(GASP u32x4*)(XG + off) = pack8(y0 * gm0, y1 * gm1); } } } }
        if (nxt) { const int lane = fr + 16 * fq; float* ssn = (float*)(w + WS_SS) + ((l + 1) & 1) * 32768 + row0;
            float sr[2][4];
#pragma unroll
            for (int ai = 0; ai < 2; ++ai)
#pragma unroll
                for (int m = 0; m < 4; ++m) { float s = part[ai][m];
                    s += __int_as_float(__builtin_amdgcn_ds_bpermute((lane ^ 16) << 2, __float_as_int(s))); s += __int_as_float(__builtin_amdgcn_ds_bpermute((lane ^ 32) << 2, __float_as_int(s))); sr[ai][m] = s; }
            const float v0 = (fq == 0) ? sr[0][0] : (fq == 1) ? sr[0][2] : (fq == 2) ? sr[1][0] : sr[1][2];
            const float v1 = (fq == 0) ? sr[0][1] : (fq == 1) ? sr[0][3] : (fq == 2) ? sr[1][1] : sr[1][3];
            float* p0 = ssn + (fq >> 1) * HALF + (fq & 1) * 32;
            (void)__builtin_amdgcn_global_atomic_fadd_f32((__attribute__((address_space(1))) float*)p0, v0);
            (void)__builtin_amdgcn_global_atomic_fadd_f32((__attribute__((address_space(1))) float*)(p0 + 16), v1); }
    }
};
template <class Epi, class Sched, bool ALIGN_EPI = false, bool SP2 = false>
__device__ __forceinline__ void gemm_phase(PG8_LAS unsigned char* lds, const Gemm g, const Sched& S, const Epi& E, const int tid) {
    const int wid = __builtin_amdgcn_readfirstlane(tid >> 6), lane = tid & 63, wr = wid >> 2, wc = wid & 3, fr = lane & 15, fq = lane >> 4;
    const int K = g.K, nt = K / BK;
    unsigned voffA[2], voffB[2];
#pragma unroll
    for (int i = 0; i < 2; ++i) { int R, C; stage_rc(tid * 16 + i * 8192, R, C); const int Rb = Epi::PERM ? ((R & ~31) + perm32(R & 31)) : R;
        voffA[i] = (unsigned)(R * g.lda + C) * 2u; voffB[i] = (unsigned)(Rb * g.ldb + C) * 2u; }
    const size_t kstep = (size_t)(BK * 2);
    const size_t hstepA = (size_t)HALF * g.lda * 2, hstepB = (size_t)HALF * g.ldb * 2;
    const unsigned ldsw = (unsigned)wid * 1024u;
    const int aoff = lds_byte(wr * 64 + fr, fq * 8), boff = lds_byte(wc * 32 + fr, fq * 8);
#define PG8_SA(b, h) (((b) * 2 + (h)) * HTB)
#define PG8_SB(b, h) ((4 + (b) * 2 + (h)) * HTB)
#define PG8_STAGE(bufoff, gbase, voff) do { _Pragma("unroll") for (int _i = 0; _i < 2; ++_i) \
        __builtin_amdgcn_global_load_lds((const unsigned*)((const char*)(gbase) + (voff)[_i]), (PG8_LAS unsigned*)(lds + (bufoff) + ldsw + _i * 8192), 16, 0, 0); } while (0)
#define PG8_LDA(dst, b, h) do { _Pragma("unroll") for (int m = 0; m < 4; ++m) _Pragma("unroll") for (int k = 0; k < 2; ++k) dst[m][k] = *(const PG8_LAS bf16x8*)(lds + PG8_SA(b, h) + aoff + m * 2048 + k * 1024); } while (0)
#define PG8_LDB(dst, b, h) do { _Pragma("unroll") for (int n = 0; n < 2; ++n) _Pragma("unroll") for (int k = 0; k < 2; ++k) dst[n][k] = *(const PG8_LAS bf16x8*)(lds + PG8_SB(b, h) + boff + n * 2048 + k * 1024); } while (0)
#define PG8_MMA(ai, bj, At, Bt) do { __builtin_amdgcn_s_setprio(1); _Pragma("unroll") for (int m = 0; m < 4; ++m) _Pragma("unroll") for (int n = 0; n < 2; ++n) _Pragma("unroll") for (int k = 0; k < 2; ++k) \
        acc[ai][bj][m][n] = __builtin_amdgcn_mfma_f32_16x16x32_bf16(Bt[n][k], At[m][k], acc[ai][bj][m][n], 0, 0, 0); __builtin_amdgcn_s_setprio(0); } while (0)
#define PG8_WAIT_V(n) asm volatile("s_waitcnt vmcnt(" #n ")" ::: "memory")
#define PG8_WAIT_L(n) asm volatile("s_waitcnt lgkmcnt(" #n ")" ::: "memory")
#define PG8_BAR __builtin_amdgcn_s_barrier()
#define PG8_SCHED __builtin_amdgcn_sched_barrier(0)
    Unit cur, nxt; int ui = 0;
    if (!S.next(0, cur)) return;
    f32x4 acc[2][2][4][2];
#pragma unroll
    for (int a = 0; a < 2; ++a)
#pragma unroll
        for (int b = 0; b < 2; ++b)
#pragma unroll
            for (int m = 0; m < 4; ++m)
#pragma unroll
                for (int n = 0; n < 2; ++n) acc[a][b][m][n] = (f32x4){0.f, 0.f, 0.f, 0.f};
    bf16x8 At[4][2], B0[2][2], B1[2][2];
    const char* cA = (const char*)g.A + (size_t)cur.pm * 2 * hstepA; const char* cB = (const char*)g.Bt + ((size_t)(cur.pm / g.grp_tiles) * g.grp_brows + (size_t)cur.pn * BM) * g.ldb * 2;
    S.a_ready(cur);
    if constexpr (SP2) {
        PG8_STAGE(PG8_SB(0, 0), cB, voffB); PG8_STAGE(PG8_SB(0, 1), cB + hstepB, voffB); PG8_STAGE(PG8_SA(0, 0), cA, voffA); PG8_STAGE(PG8_SA(0, 1), cA + hstepA, voffA);
        if (wr == 1) PG8_BAR;
        PG8_WAIT_V(2); PG8_BAR;
        PG8_STAGE(PG8_SB(1, 0), cB + kstep, voffB); PG8_STAGE(PG8_SA(1, 0), cA + kstep, voffA); PG8_STAGE(PG8_SB(1, 1), cB + hstepB + kstep, voffB);
        PG8_WAIT_V(6); PG8_BAR;
    } else {
        PG8_STAGE(PG8_SB(0, 0), cB, voffB); PG8_STAGE(PG8_SA(0, 0), cA, voffA); PG8_STAGE(PG8_SB(0, 1), cB + hstepB, voffB); PG8_STAGE(PG8_SA(0, 1), cA + hstepA, voffA);
        if (wr == 1) PG8_BAR;
        PG8_WAIT_V(4); PG8_BAR;
        PG8_STAGE(PG8_SB(1, 0), cB + kstep, voffB); PG8_STAGE(PG8_SA(1, 0), cA + kstep, voffA); PG8_STAGE(PG8_SB(1, 1), cB + hstepB + kstep, voffB);
        PG8_WAIT_V(6); PG8_BAR;
    }
    for (;;) {
        const bool has_next = S.next(ui + 1, nxt);
        const char* nA = has_next ? (const char*)g.A + (size_t)nxt.pm * 2 * hstepA : cA; const char* nB = has_next ? (const char*)g.Bt + ((size_t)(nxt.pm / g.grp_tiles) * g.grp_brows + (size_t)nxt.pn * BM) * g.ldb * 2 : cB;
        for (int t = 0; t < nt; t += 2) {
            const bool last = (t == nt - 2);
            const char* a1 = cA + (size_t)(t + 1) * kstep;
            const char* a2 = last ? nA : cA + (size_t)(t + 2) * kstep; const char* b2 = last ? nB : cB + (size_t)(t + 2) * kstep;
            const char* a3 = a2 + kstep; const char* b3 = b2 + kstep;
            if (last && has_next) S.a_ready(nxt);
            if constexpr (SP2) {
            PG8_LDB(B0, 0, 0); PG8_LDB(B1, 0, 1); PG8_SCHED; PG8_LDA(At, 0, 0); PG8_STAGE(PG8_SA(1, 1), a1 + hstepA, voffA);
            PG8_WAIT_V(8); PG8_WAIT_L(0); PG8_BAR; PG8_MMA(0, 0, At, B0); PG8_MMA(0, 1, At, B1); PG8_BAR; PG8_SCHED;
            PG8_LDA(At, 0, 1); PG8_STAGE(PG8_SB(0, 0), b2, voffB); PG8_STAGE(PG8_SB(0, 1), b2 + hstepB, voffB); PG8_STAGE(PG8_SA(0, 0), a2, voffA);
            PG8_WAIT_V(8); PG8_WAIT_L(0); PG8_BAR; PG8_MMA(1, 0, At, B0); PG8_MMA(1, 1, At, B1); PG8_BAR; PG8_SCHED;
            PG8_LDB(B0, 1, 0); PG8_LDB(B1, 1, 1); PG8_SCHED; PG8_LDA(At, 1, 0); PG8_STAGE(PG8_SA(0, 1), a2 + hstepA, voffA);
            PG8_WAIT_V(8); PG8_WAIT_L(0); PG8_BAR; PG8_MMA(0, 0, At, B0); PG8_MMA(0, 1, At, B1); PG8_BAR; PG8_SCHED;
            PG8_LDA(At, 1, 1); PG8_STAGE(PG8_SB(1, 0), b3, voffB); PG8_STAGE(PG8_SB(1, 1), b3 + hstepB, voffB); PG8_STAGE(PG8_SA(1, 0), a3, voffA);
            PG8_WAIT_V(8); PG8_WAIT_L(0); PG8_BAR; PG8_MMA(1, 0, At, B0); PG8_MMA(1, 1, At, B1); PG8_BAR; PG8_SCHED;
            } else {
            PG8_LDB(B0, 0, 0); PG8_SCHED; PG8_LDA(At, 0, 0); PG8_STAGE(PG8_SA(1, 1), a1 + hstepA, voffA);
            PG8_WAIT_L(8); PG8_BAR; PG8_WAIT_L(0); PG8_MMA(0, 0, At, B0); PG8_BAR; PG8_SCHED;
            PG8_LDB(B1, 0, 1); PG8_STAGE(PG8_SB(0, 0), b2, voffB);
            PG8_BAR; PG8_WAIT_L(0); PG8_MMA(0, 1, At, B1); PG8_BAR;
            PG8_LDA(At, 0, 1); PG8_STAGE(PG8_SA(0, 0), a2, voffA);
            PG8_BAR; PG8_WAIT_L(0); PG8_MMA(1, 0, At, B0); PG8_BAR; PG8_SCHED;
            PG8_STAGE(PG8_SB(0, 1), b2 + hstepB, voffB);
            PG8_WAIT_V(6); PG8_BAR; PG8_MMA(1, 1, At, B1); PG8_BAR;
            PG8_LDB(B0, 1, 0); PG8_SCHED; PG8_LDA(At, 1, 0); PG8_STAGE(PG8_SA(0, 1), a2 + hstepA, voffA);
            PG8_WAIT_L(8); PG8_BAR; PG8_WAIT_L(0); PG8_MMA(0, 0, At, B0); PG8_BAR; PG8_SCHED;
            PG8_LDB(B1, 1, 1); PG8_STAGE(PG8_SB(1, 0), b3, voffB);
            PG8_BAR; PG8_WAIT_L(0); PG8_MMA(0, 1, At, B1); PG8_BAR;
            PG8_LDA(At, 1, 1); PG8_STAGE(PG8_SA(1, 0), a3, voffA);
            PG8_BAR; PG8_WAIT_L(0); PG8_MMA(1, 0, At, B0); PG8_BAR; PG8_SCHED;
            PG8_STAGE(PG8_SB(1, 1), b3 + hstepB, voffB);
            PG8_WAIT_V(6); PG8_BAR; PG8_MMA(1, 1, At, B1); PG8_BAR;
            }
        }
        if constexpr (ALIGN_EPI) { if (wr == 0) PG8_BAR; }
        if constexpr (!Epi::AFTER_DRAIN) { int wr_e = wr, wc_e = wc, fr_e = fr, fq_e = fq; asm volatile("" : "+s"(wr_e), "+s"(wc_e), "+v"(fr_e), "+v"(fq_e)); E(acc, cur, wr_e, wc_e, fr_e, fq_e); S.done(cur); }
        if (!has_next) break;
#pragma unroll
        for (int a = 0; a < 2; ++a)
#pragma unroll
            for (int b = 0; b < 2; ++b)
#pragma unroll
                for (int m = 0; m < 4; ++m)
#pragma unroll
                    for (int n = 0; n < 2; ++n) acc[a][b][m][n] = (f32x4){0.f, 0.f, 0.f, 0.f};
        cur = nxt; cA = nA; cB = nB; ++ui;
        if constexpr (ALIGN_EPI) { if (wr == 1) PG8_BAR; }
    }
    PG8_WAIT_V(0);
    if constexpr (!ALIGN_EPI) { if (wr == 0) PG8_BAR; }
    PG8_BAR;
    if constexpr (Epi::AFTER_DRAIN) { E.fused(acc, cur, wr, wc, fr, fq, lds, wid, lane); S.done(cur); }
#undef PG8_SA
#undef PG8_SB
#undef PG8_STAGE
#undef PG8_LDA
#undef PG8_LDB
#undef PG8_MMA
#undef PG8_WAIT_V
#undef PG8_WAIT_L
#undef PG8_BAR
#undef PG8_SCHED
}
}
#include <hip/hip_bf16.h>
#include <cmath>
namespace attn_body {
using bf16=__hip_bfloat16;
using bf16x8=__attribute__((ext_vector_type(8)))short;
using s16x4=__attribute__((ext_vector_type(4)))short;
using f32x16=__attribute__((ext_vector_type(16)))float;
using u32x4=__attribute__((ext_vector_type(4)))unsigned;
constexpr int BATCH=8,NHEAD=16,SEQ=4096,D=64,DM=NHEAD*D;
constexpr int NW=8,QBLK=32,QB=QBLK*NW,KVBLK=64,NQB=SEQ/QB;
constexpr int ATTN_PITCH=DM, ATTN_UNIT_ROWS=QB;
__device__ __forceinline__ int crow(int r,int hi){return (r&3)+8*(r>>2)+4*hi;}
#define SBAR() __builtin_amdgcn_sched_barrier(0)
__device__ __forceinline__ void cmask(f32x16&p0,f32x16&p1,int jb,int qrel,int hi){
  const float NEG=-INFINITY; int kb=64*jb+4*hi;
  #pragma unroll
  for(int r=0;r<16;++r){int kv=kb+(r&3)+8*(r>>2); if(kv>qrel)p0[r]=NEG; if(kv+32>qrel)p1[r]=NEG;}
}

constexpr int NSLOT=3, SLOTB=8192;
constexpr int LDS_K=0, LDS_V=NSLOT*SLOTB, LDS_WS=2*NSLOT*SLOTB, LDS_OST=LDS_WS+NW*64*4, LDS_BYTES=LDS_OST+NW*4096;
constexpr float C2=0.125f*1.4426950408889634f;
__device__ __forceinline__ void glds16(const void*gsrc,unsigned lds_dst){unsigned keep;
  asm volatile("s_mov_b32 %0, m0\n\ts_mov_b32 m0, %2\n\ts_nop 0\n\tglobal_load_lds_dwordx4 %1, off\n\ts_mov_b32 m0, %0":"=&s"(keep):"v"(gsrc),"s"(lds_dst):"memory");}
__device__ __forceinline__ float max3f(float a,float b,float c){float r;asm("v_max3_f32 %0, %1, %2, %3":"=v"(r):"v"(a),"v"(b),"v"(c));return r;}
__device__ __forceinline__ float max2f(float a,float b){float r;asm("v_max_f32_e32 %0, %1, %2":"=v"(r):"v"(a),"v"(b));return r;}
__device__ __forceinline__ float fadd_s(float a,float b){float r;asm("v_add_f32_e32 %0, %1, %2":"=v"(r):"v"(a),"v"(b));return r;}
__device__ __forceinline__ float fsub_s(float a,float b){float r;asm("v_sub_f32_e32 %0, %1, %2":"=v"(r):"v"(a),"v"(b));return r;}
typedef float f32x2_t __attribute__((ext_vector_type(2))); typedef __bf16 bf16x2_t __attribute__((ext_vector_type(2)));
__device__ __forceinline__ unsigned cvtpk_s(float lo,float hi){f32x2_t v={lo,hi};bf16x2_t b=__builtin_convertvector(v,bf16x2_t);return __builtin_bit_cast(unsigned,b);}
#define WAIT_BAR(N) asm volatile("s_waitcnt vmcnt(" #N ") lgkmcnt(0)\n\ts_barrier":::"memory")

__device__ __forceinline__ void qkt(f32x16&p0,f32x16&p1,const char*Kslot,const bf16x8*qr,const f32x16&negm,int r32,int hi){
  const char*kb=Kslot+hi*1024+r32*16;
  #pragma unroll
  for(int d0=0;d0<4;++d0){
    const bf16x8 b0=*reinterpret_cast<const bf16x8*>(kb+d0*2048);
    const bf16x8 b1=*reinterpret_cast<const bf16x8*>(kb+d0*2048+512);
    if(d0==0){p0=__builtin_amdgcn_mfma_f32_32x32x16_bf16(b0,qr[0],negm,0,0,0);p1=__builtin_amdgcn_mfma_f32_32x32x16_bf16(b1,qr[0],negm,0,0,0);}
    else{p0=__builtin_amdgcn_mfma_f32_32x32x16_bf16(b0,qr[d0],p0,0,0,0);p1=__builtin_amdgcn_mfma_f32_32x32x16_bf16(b1,qr[d0],p1,0,0,0);}}
}
typedef __attribute__((address_space(3))) const char* lds_cptr;
typedef short v4i16_t __attribute__((ext_vector_type(4)));
__device__ __forceinline__ void kload8(bf16x8*kf,lds_cptr kp){
  kf[0]=*(const __attribute__((address_space(3))) bf16x8*)(kp);      kf[1]=*(const __attribute__((address_space(3))) bf16x8*)(kp+512);
  kf[2]=*(const __attribute__((address_space(3))) bf16x8*)(kp+2048); kf[3]=*(const __attribute__((address_space(3))) bf16x8*)(kp+2560);
  kf[4]=*(const __attribute__((address_space(3))) bf16x8*)(kp+4096); kf[5]=*(const __attribute__((address_space(3))) bf16x8*)(kp+4608);
  kf[6]=*(const __attribute__((address_space(3))) bf16x8*)(kp+6144); kf[7]=*(const __attribute__((address_space(3))) bf16x8*)(kp+6656);
}
__device__ __forceinline__ void kload2(bf16x8*kf,lds_cptr kp,int j){ kf[2*j]=*(const __attribute__((address_space(3))) bf16x8*)(kp+j*2048); kf[2*j+1]=*(const __attribute__((address_space(3))) bf16x8*)(kp+j*2048+512); }
__device__ __forceinline__ s16x4 vtr(lds_cptr p){ return __builtin_bit_cast(s16x4,__builtin_amdgcn_ds_read_tr16_b64_v4i16((__attribute__((address_space(3))) v4i16_t*)p)); }
__device__ __forceinline__ float rowmax(const f32x16&p0,const f32x16&p1){
  float a=max3f(p0[0],p0[1],p1[0]),b=max3f(p0[2],p0[3],p1[1]);a=max3f(a,p1[2],p1[3]);
  #pragma unroll
  for(int r=4;r<16;r+=4){a=max3f(a,p0[r],p0[r+1]);b=max3f(b,p0[r+2],p0[r+3]);a=max3f(a,p1[r],p1[r+1]);b=max3f(b,p1[r+2],p1[r+3]);}
  const float m=max2f(a,b);
  auto rr=__builtin_amdgcn_permlane32_swap(__float_as_uint(m),__float_as_uint(m),false,false);
  return max2f(__uint_as_float(rr[0]),__uint_as_float(rr[1]));
}
__device__ __forceinline__ void pv(f32x16*o,int vb,bf16x8 pa0,bf16x8 pa1,bf16x8 pa2,bf16x8 pa3){
  #pragma unroll
  for(int d0=0;d0<2;++d0){s16x4 lo[4],hi[4];
    #pragma unroll
    for(int ks=0;ks<4;++ks){
      asm volatile("ds_read_b64_tr_b16 %0,%1 offset:%c2":"=&v"(lo[ks]):"v"(vb),"i"(d0*4096+ks*1024):"memory");
      asm volatile("ds_read_b64_tr_b16 %0,%1 offset:%c2":"=&v"(hi[ks]):"v"(vb),"i"(d0*4096+ks*1024+512):"memory");}
    asm volatile("s_waitcnt lgkmcnt(0)":::"memory");SBAR();
    #define PK(k) (bf16x8){lo[k][0],lo[k][1],lo[k][2],lo[k][3],hi[k][0],hi[k][1],hi[k][2],hi[k][3]}
    o[d0]=__builtin_amdgcn_mfma_f32_32x32x16_bf16(pa0,PK(0),o[d0],0,0,0);
    o[d0]=__builtin_amdgcn_mfma_f32_32x32x16_bf16(pa1,PK(1),o[d0],0,0,0);
    o[d0]=__builtin_amdgcn_mfma_f32_32x32x16_bf16(pa2,PK(2),o[d0],0,0,0);
    o[d0]=__builtin_amdgcn_mfma_f32_32x32x16_bf16(pa3,PK(3),o[d0],0,0,0);
    #undef PK
  }
}

#ifndef ATTN_STORE16
#define ATTN_STORE16(p,v) (*(GASP u32x4*)(p)=(v))
#endif
template<int THRL> __device__ __forceinline__ void attn_unit(int b,int qc,int vc,int qb,const bf16*Q,const bf16*__restrict__ K,const bf16*__restrict__ V,bf16*O,char*shm,const int tid){
  const int lane=tid&63,r32=lane&31,hi=lane>>5; const int wid=__builtin_amdgcn_readfirstlane(tid>>6);
  const long rowbase=(long)b*SEQ; const int q0=qb*QB;
  const bf16*Qw=Q+(rowbase+q0+wid*QBLK)*DM+qc;
  const bf16*Kh=K+rowbase*DM+qc,*Vh=V+rowbase*DM+vc;
  const unsigned lds0=(unsigned)(uintptr_t)shm;
  float*wsf=(float*)(shm+LDS_WS)+wid*64;
  const bf16*ksrc=Kh+(long)lane*DM+wid*8;
  const bf16*vsrc=Vh+(long)(16*(wid&3)+(lane>>2))*DM+(wid>>2)*32+(lane&3)*8;
  const unsigned kdst=lds0+LDS_K+wid*1024, vdst=lds0+LDS_V+wid*1024;
  #define DMA_K(t,slot) glds16(ksrc+(long)(t)*KVBLK*DM,(unsigned)__builtin_amdgcn_readfirstlane(kdst+(slot)))
  #define DMA_V(t,slot) glds16(vsrc+(long)(t)*KVBLK*DM,(unsigned)__builtin_amdgcn_readfirstlane(vdst+(slot)))
  const int vb0=(int)(lds0+LDS_V)+((lane>>4)&1)*32+(lane&3)*8+(4*hi+((lane&15)>>2))*64;
  const char*Kbase=shm+LDS_K; bf16x8 kf[8];
  const lds_cptr shm3=(lds_cptr)shm; const lds_cptr kp0=shm3+LDS_K+hi*1024+r32*16; const lds_cptr vp0=shm3+LDS_V+((lane>>4)&1)*32+(lane&3)*8+(4*hi+((lane&15)>>2))*64;
  const int NT=(q0+QB)/KVBLK;
  DMA_K(0,0);DMA_V(0,0);DMA_K(1,SLOTB);
  bf16x8 qr[4];
  #pragma unroll
  for(int d0=0;d0<4;++d0)qr[d0]=*(const GASP bf16x8*)(&Qw[(long)r32*DM+d0*16+hi*8]);
  float zf_=0.f;asm volatile("":"+v"(zf_));float mhat=zf_,l_reg=zf_;f32x16 o[2],negm;
  #pragma unroll
  for(int r=0;r<16;++r){o[0][r]=zf_;o[1][r]=zf_;negm[r]=zf_;}
  asm volatile("":"+v"(negm));
  const int qrel=wid*QBLK+r32;
  #define CMASK(P0,P1,t) do{int jb_=(t)-(NT-4); if(jb_>=0)cmask(P0,P1,jb_,qrel,hi);}while(0)
  bool resc=false;
  #define START(P0,P1) do{ const float rm=rowmax(P0,P1); resc=false; \
    { const float dl=rm; mhat=fadd_s(mhat,dl); \
      _Pragma("unroll") for(int r=0;r<16;++r){P0[r]=fsub_s(P0[r],dl);P1[r]=fsub_s(P1[r],dl);} \
      _Pragma("unroll") for(int r=0;r<16;++r)negm[r]=-mhat; asm volatile("":"+v"(negm)); } \
    _Pragma("unroll") for(int r=0;r<16;++r)P0[r]=__builtin_amdgcn_exp2f(P0[r]); }while(0)
  #define RESC() do{ if(resc){ asm volatile("s_waitcnt lgkmcnt(0)":::"memory"); \
      _Pragma("unroll") for(int d_=0;d_<2;++d_) _Pragma("unroll") for(int r=0;r<16;++r)o[d_][r]*=wsf[crow(r,hi)]; } }while(0)
  f32x16 pA0,pA1,pB0,pB1;
  int sl_prev=0,sl_cur=0,sl_next=SLOTB;
  #define ROT() do{sl_prev=sl_cur;sl_cur=sl_next;sl_next=(sl_next==(NSLOT-1)*SLOTB)?0:sl_next+SLOTB;}while(0)
  DMA_K(2,2*SLOTB);
  WAIT_BAR(3);
  qkt(pA0,pA1,Kbase,qr,negm,r32,hi);asm volatile("s_nop 15\n\ts_nop 7":"+v"(pA0),"+v"(pA1));CMASK(pA0,pA1,0);
  START(pA0,pA1);
  _Pragma("unroll") for(int r=0;r<16;++r)pA1[r]=__builtin_amdgcn_exp2f(pA1[r]);
  WAIT_BAR(0);
  DMA_K(3,0);DMA_V(1,SLOTB);
  ROT();
  kload8(kf,kp0+sl_cur);
  WAIT_BAR(2);
  s16x4 vlo[8],vhi[8]; u32x4 pw0,pw1,pw2,pw3;
  #define PKW(P,B) cvtpk_s(P[B],P[B+1])
  #define PAF(k) __builtin_bit_cast(bf16x8,pw##k)
  #define VFR(i) (bf16x8){vlo[i][0],vlo[i][1],vlo[i][2],vlo[i][3],vhi[i][0],vhi[i][1],vhi[i][2],vhi[i][3]}
  #define PIN(x) asm volatile("":"+v"(x))
  #define MX3(a,b,c) __builtin_fmaxf(__builtin_fmaxf((a),(b)),(c))
  #define GAPA(MF,A0,A1,A2,A3,W0,W1,PW) do{ MF; sacc+=A0; sacc+=A1; sacc+=A2; sacc+=A3; PIN(sacc); W0; W1; PIN(PW); SBAR(); }while(0)
  #define EX(v) __builtin_amdgcn_exp2f(v)
  #define GAPB(MF,X,B) do{ MF; X[B]=EX(X[B]); X[B+1]=EX(X[B+1]); X[B+2]=EX(X[B+2]); X[B+3]=EX(X[B+3]); PIN(X); SBAR(); }while(0)
  #define VRD(i) do{ vlo[i]=vtr(vp_+(((i)>>2)*4096+((i)&3)*1024)); vhi[i]=vtr(vp_+(((i)>>2)*4096+((i)&3)*1024+512)); }while(0)
  #define KRD(G,j) do{ if(G){ kload2(kf,kp0+sl_next,j); SBAR(); } }while(0)
  #define STEP(C0,C1,P0,P1,t,GK,GV,GL) do{ SBAR(); \
    const lds_cptr vp_=vp0+sl_prev; \
    VRD(0); SBAR(); float sacc=(P0[0]+P0[1]); \
    GAPA(C0=__builtin_amdgcn_mfma_f32_32x32x16_bf16(kf[0],qr[0],negm,0,0,0), P0[2],P0[3],P0[4],P0[5],     pw0[0]=PKW(P0,0), pw0[1]=PKW(P0,2), pw0); \
    VRD(4); SBAR(); GAPA(C1=__builtin_amdgcn_mfma_f32_32x32x16_bf16(kf[1],qr[0],negm,0,0,0), P0[6],P0[7],P0[8],P0[9],     pw0[2]=PKW(P0,4), pw0[3]=PKW(P0,6), pw0); \
    VRD(1); SBAR(); GAPA(C0=__builtin_amdgcn_mfma_f32_32x32x16_bf16(kf[2],qr[1],C0,0,0,0),   P0[10],P0[11],P0[12],P0[13], pw1[0]=PKW(P0,8), pw1[1]=PKW(P0,10), pw1); \
    VRD(5); SBAR(); GAPA(C1=__builtin_amdgcn_mfma_f32_32x32x16_bf16(kf[3],qr[1],C1,0,0,0),   P0[14],P0[15],P1[0],P1[1],   pw1[2]=PKW(P0,12),pw1[3]=PKW(P0,14), pw1); \
    VRD(2); SBAR(); GAPA(C0=__builtin_amdgcn_mfma_f32_32x32x16_bf16(kf[4],qr[2],C0,0,0,0),   P1[2],P1[3],P1[4],P1[5],     pw2[0]=PKW(P1,0), pw2[1]=PKW(P1,2), pw2); \
    VRD(6); SBAR(); GAPA(C1=__builtin_amdgcn_mfma_f32_32x32x16_bf16(kf[5],qr[2],C1,0,0,0),   P1[6],P1[7],P1[8],P1[9],     pw2[2]=PKW(P1,4), pw2[3]=PKW(P1,6), pw2); \
    VRD(3); SBAR(); GAPA(C0=__builtin_amdgcn_mfma_f32_32x32x16_bf16(kf[6],qr[3],C0,0,0,0),   P1[10],P1[11],P1[12],P1[13], pw3[0]=PKW(P1,8), pw3[1]=PKW(P1,10), pw3); \
    VRD(7); SBAR(); GAPA(C1=__builtin_amdgcn_mfma_f32_32x32x16_bf16(kf[7],qr[3],C1,0,0,0),   P1[14],P1[15],0.f,0.f,       pw3[2]=PKW(P1,12),pw3[3]=PKW(P1,14), pw3); \
    l_reg+=sacc; \
    if(GK){DMA_K((t)+3,sl_cur);} if(GV){DMA_V((t)+1,sl_next);} \
    CMASK(C0,C1,t); \
    { float a=MX3(C0[0],C0[1],C1[0]),b=MX3(C0[2],C0[3],C1[1]); a=MX3(a,C1[2],C1[3]); \
      _Pragma("unroll") for(int r=4;r<16;r+=4){a=MX3(a,C0[r],C0[r+1]);b=MX3(b,C0[r+2],C0[r+3]);a=MX3(a,C1[r],C1[r+1]);b=MX3(b,C1[r+2],C1[r+3]);} \
      float rm=__builtin_fmaxf(a,b); { auto rr=__builtin_amdgcn_permlane32_swap(__float_as_uint(rm),__float_as_uint(rm),false,false); rm=__builtin_fmaxf(__uint_as_float(rr[0]),__uint_as_float(rr[1])); } \
      resc=false; \
      if(__builtin_expect(__any(rm>(float)THRL),0)){ const float dl=__builtin_fmaxf(rm,0.f); mhat+=dl; \
        _Pragma("unroll") for(int r=0;r<16;++r){C0[r]-=dl;C1[r]-=dl;} \
        _Pragma("unroll") for(int r=0;r<16;++r)negm[r]=-mhat; asm volatile("":"+v"(negm)); \
        const float f=__builtin_amdgcn_exp2f(-dl); l_reg*=f; if(hi==0)wsf[r32]=f; resc=true; } } \
    SBAR(); \
    GAPB(o[0]=__builtin_amdgcn_mfma_f32_32x32x16_bf16(PAF(0),VFR(0),o[0],0,0,0), C0,0); \
    GAPB(o[1]=__builtin_amdgcn_mfma_f32_32x32x16_bf16(PAF(0),VFR(4),o[1],0,0,0), C0,4); \
    KRD(GL,0); GAPB(o[0]=__builtin_amdgcn_mfma_f32_32x32x16_bf16(PAF(1),VFR(1),o[0],0,0,0), C0,8); \
    KRD(GL,1); GAPB(o[1]=__builtin_amdgcn_mfma_f32_32x32x16_bf16(PAF(1),VFR(5),o[1],0,0,0), C0,12); \
    KRD(GL,2); GAPB(o[0]=__builtin_amdgcn_mfma_f32_32x32x16_bf16(PAF(2),VFR(2),o[0],0,0,0), C1,0); \
    KRD(GL,3); GAPB(o[1]=__builtin_amdgcn_mfma_f32_32x32x16_bf16(PAF(2),VFR(6),o[1],0,0,0), C1,4); \
    GAPB(o[0]=__builtin_amdgcn_mfma_f32_32x32x16_bf16(PAF(3),VFR(3),o[0],0,0,0), C1,8); \
    GAPB(o[1]=__builtin_amdgcn_mfma_f32_32x32x16_bf16(PAF(3),VFR(7),o[1],0,0,0), C1,12); \
    }while(0)
  int t=1;
  #undef CMASK
  #define CMASK(P0,P1,t) do{}while(0)
  for(;t+5<NT;t+=2){
    STEP(pB0,pB1,pA0,pA1,t,true,true,true);     WAIT_BAR(2); RESC(); ROT();
    STEP(pA0,pA1,pB0,pB1,t+1,true,true,true);   WAIT_BAR(2); RESC(); ROT();
  }
  #undef CMASK
  #define CMASK(P0,P1,t) do{int jb_=(t)-(NT-4); if(jb_>=0)cmask(P0,P1,jb_,qrel,hi);}while(0)
  #define ENDW(tt) do{ if((tt)+3<NT){WAIT_BAR(2);} else if((tt)+2<NT){WAIT_BAR(1);} else {WAIT_BAR(0);} }while(0)
  for(;t+1<NT;t+=2){
    STEP(pB0,pB1,pA0,pA1,t,(t+3<NT),(t+1<NT),(t+1<NT));       ENDW(t);   RESC(); ROT();
    STEP(pA0,pA1,pB0,pB1,t+1,(t+4<NT),(t+2<NT),(t+2<NT));     ENDW(t+1); RESC(); ROT();
  }
  STEP(pB0,pB1,pA0,pA1,NT-1,false,false,false); RESC();
  { float sacc=pB0[0]+pB0[1]; _Pragma("unroll") for(int r=2;r<16;++r)sacc+=pB0[r]; _Pragma("unroll") for(int r=0;r<16;++r)sacc+=pB1[r]; l_reg+=sacc;
    pw0=(u32x4){PKW(pB0,0),PKW(pB0,2),PKW(pB0,4),PKW(pB0,6)};pw1=(u32x4){PKW(pB0,8),PKW(pB0,10),PKW(pB0,12),PKW(pB0,14)};pw2=(u32x4){PKW(pB1,0),PKW(pB1,2),PKW(pB1,4),PKW(pB1,6)};pw3=(u32x4){PKW(pB1,8),PKW(pB1,10),PKW(pB1,12),PKW(pB1,14)};
    SBAR(); pv(o,vb0+sl_cur,PAF(0),PAF(1),PAF(2),PAF(3)); }
  #undef PKW
  #undef PAF
  #undef VFR
  #undef PIN
  #undef MX3
  #undef GAPA
  #undef GAPB
  #undef EX
  #undef VRD
  #undef KRD
  #undef STEP
  #undef ENDW
  {auto rr=__builtin_amdgcn_permlane32_swap(__float_as_uint(l_reg),__float_as_uint(l_reg),false,false);l_reg=__uint_as_float(rr[0])+__uint_as_float(rr[1]);}
  if(hi==0)wsf[32+r32]=l_reg;asm volatile("s_waitcnt lgkmcnt(0)":::"memory");
  float rli[16];
  #pragma unroll
  for(int r=0;r<16;++r)rli[r]=__builtin_amdgcn_rcpf(wsf[32+crow(r,hi)]);
  bf16*Ow=O+(rowbase+q0+wid*QBLK)*DM+vc;
  { bf16*stg=(bf16*)(shm+LDS_OST)+wid*2048;
    #pragma unroll
    for(int r=0;r<16;++r){const int orow=crow(r,hi);
      #pragma unroll
      for(int d0=0;d0<2;++d0)stg[orow*64+d0*32+r32]=__float2bfloat16(o[d0][r]*rli[r]);}
    asm volatile("s_waitcnt lgkmcnt(0)":::"memory");
    #pragma unroll
    for(int i=0;i<4;++i){const int row=i*8+(lane>>3),ch=lane&7; const u32x4 v=*(const u32x4*)(stg+row*64+ch*8); ATTN_STORE16(Ow+(long)row*DM+ch*8,v);} }
  asm volatile("s_waitcnt lgkmcnt(0)\n\ts_barrier":::"memory");
  #undef DMA_K
  #undef DMA_V
  #undef CMASK
  #undef START
  #undef RESC
  #undef ROT
}
constexpr int ATTN_LDS_BYTES=LDS_BYTES;
#undef SBAR
#undef WAIT_BAR
}

#define LAS __attribute__((address_space(3)))
typedef unsigned short bf16;
typedef unsigned v4u __attribute__((ext_vector_type(4)));
typedef unsigned v2u __attribute__((ext_vector_type(2)));
typedef float f32x4 __attribute__((ext_vector_type(4)));

__device__ __forceinline__ float lane_xor(float v, int lane, int o) { return __int_as_float(__builtin_amdgcn_ds_bpermute((lane ^ o) << 2, __float_as_int(v))); }
__device__ __forceinline__ float wave_sum(float v, int lane) {
#pragma unroll
    for (int o = 1; o < 64; o <<= 1) v += lane_xor(v, lane, o);
    return v;
}
__device__ __forceinline__ unsigned f2bf(float f) { unsigned u = __builtin_bit_cast(unsigned, f); return (u + 0x7fffu + ((u >> 16) & 1u)) >> 16; }
__device__ __forceinline__ unsigned pk2(float lo, float hi) { return f2bf(lo) | (f2bf(hi) << 16); }
__device__ __forceinline__ float bflo(unsigned w) { return __uint_as_float(w << 16); }
__device__ __forceinline__ float bfhi(unsigned w) { return __uint_as_float(w & 0xffff0000u); }
__device__ __forceinline__ void sincos_d(double ang, float& s, float& c) { double t = ang * 0.15915494309189535; t -= rint(t); const float f = (float)t; s = __builtin_amdgcn_sinf(f); c = __builtin_amdgcn_cosf(f); }

__device__ __forceinline__ void p0_transpose_item(const float* W, int K, int N, bf16* WT, int srccol0, int dstrow0, int k0, LAS float* scr, int lane) {
#pragma unroll
    for (int i = 0; i < 32; ++i) { const int kk = 2 * i + (lane >> 5); scr[kk * 33 + (lane & 31)] = W[(size_t)(k0 + kk) * N + srccol0 + (lane & 31)]; }
    asm volatile("s_waitcnt lgkmcnt(0)" ::: "memory");
    const int c = lane & 7;
#pragma unroll
    for (int j = 0; j < 4; ++j) { const int n = (lane >> 3) + 8 * j; const LAS float* s = scr + (8 * c) * 33 + n;
        v4u o; o.x = pk2(s[0 * 33], s[1 * 33]); o.y = pk2(s[2 * 33], s[3 * 33]); o.z = pk2(s[4 * 33], s[5 * 33]); o.w = pk2(s[6 * 33], s[7 * 33]);
        *(GASP v4u*)(WT + (size_t)(dstrow0 + n) * K + k0 + 8 * c) = o; }
    asm volatile("s_waitcnt lgkmcnt(0)" ::: "memory");
}
__device__ __forceinline__ int win_srccol(int r0) { const int pn = r0 >> 8, seg = pn >> 2; if (seg == 2 || seg == 3) { const int s = r0 & 255; return (pn << 8) + 64 * ((s & 127) >> 5) + 32 * (s >> 7); } return r0; }
__device__ __forceinline__ int wglu_srccol(int r0) { const int pn = r0 >> 8, s = r0 & 255; return (s >> 7) * 1024 + pn * 128 + (s & 127); }

#define XB_TMO      128
#define XB_XCNT(j)  (256  + 64 * (j))
#define XB_XSUB(j)  (1280 + 64 * (j))
#define XB_XGEN(j)  (2304 + 64 * (j))
#define XB_TOP      3328
#define XB_TOPGEN   3392
#define XCD_BAR_WORDS 3456
#define XB_SPIN_CAP (1u << 22)

__device__ __forceinline__ unsigned xb_ld(unsigned* p)              { return __hip_atomic_load(p, __ATOMIC_RELAXED, __HIP_MEMORY_SCOPE_AGENT); }
__device__ __forceinline__ unsigned xb_add(unsigned* p, unsigned v) { return __hip_atomic_fetch_add(p, v, __ATOMIC_RELAXED, __HIP_MEMORY_SCOPE_AGENT); }
__device__ __forceinline__ unsigned xb_xcc_id() { return (unsigned)__builtin_amdgcn_s_getreg((3 << 11) | 20) & 0xFu; }
#define XB_SPIN(cond, bar) do { unsigned _sp = 0; while (cond) { __builtin_amdgcn_s_sleep(1); \
    if ((++_sp & 255u) == 0u) { if (xb_ld(&(bar)[XB_TMO])) break; if (_sp > XB_SPIN_CAP) { atomicAdd(&(bar)[XB_TMO], 1u); break; } } } } while (0)

struct XcdBarrier {
    unsigned* bar; unsigned x;
    volatile LAS unsigned* st;
};

__device__ __forceinline__ XcdBarrier xcd_barrier_post(unsigned* bar, volatile LAS unsigned* st) {
    XcdBarrier b; b.bar = bar; b.x = xb_xcc_id(); b.st = st;
    if (threadIdx.x == 0) (void)xb_add(&bar[XB_XCNT(b.x)], 1u);
    return b;
}
__device__ __forceinline__ void xcd_barrier_complete(unsigned* bar, unsigned x, unsigned& nloc, unsigned& nx) {
    const unsigned G = gridDim.x * gridDim.y * gridDim.z;
    unsigned sum, cnt, mine, sp = 0u;
    for (;;) {
        sum = 0u; cnt = 0u; mine = 0u;
#pragma unroll
        for (unsigned j = 0; j < 16; ++j) { const unsigned c = xb_ld(&bar[XB_XCNT(j)]); sum += c; cnt += (c > 0u) ? 1u : 0u; mine = (j == x) ? c : mine; }
        if (sum == G) break;
        __builtin_amdgcn_s_sleep(1);
        if ((++sp & 255u) == 0u) { if (xb_ld(&bar[XB_TMO])) break; if (sp > XB_SPIN_CAP) { atomicAdd(&bar[XB_TMO], 1u); break; } }
    }
    nloc = mine > 0u ? mine : 1u; nx = cnt > 0u ? cnt : 1u;
}

__device__ __forceinline__ void xcd_barrier(const XcdBarrier& b) {
    asm volatile("s_waitcnt vmcnt(0)" ::: "memory");
    __syncthreads();
    if (threadIdx.x == 0) {
        unsigned* bar = b.bar;
        __builtin_amdgcn_s_waitcnt(0);
        unsigned nloc = b.st[0], nx = b.st[1];
        if (nloc == 0u) { xcd_barrier_complete(bar, b.x, nloc, nx); b.st[0] = nloc; b.st[1] = nx; }
        const unsigned old = xb_add(&bar[XB_XSUB(b.x)], 1u);
        const unsigned gen = old / nloc;
        if (old + 1u == (gen + 1u) * nloc) {
            __builtin_amdgcn_fence(__ATOMIC_RELEASE, "agent");
            asm volatile("s_waitcnt vmcnt(0)" ::: "memory");
            const unsigned og = xb_add(&bar[XB_TOP], 1u);
            const unsigned tg = og / nx;
            if (og + 1u == (tg + 1u) * nx) xb_add(&bar[XB_TOPGEN], 1u);
            else XB_SPIN(xb_ld(&bar[XB_TOPGEN]) == tg, bar);
            __builtin_amdgcn_fence(__ATOMIC_ACQUIRE, "agent");
            xb_add(&bar[XB_XGEN(b.x)], 1u);
            asm volatile("s_waitcnt vmcnt(0)" ::: "memory");
        } else {
            XB_SPIN(xb_ld(&bar[XB_XGEN(b.x)]) == gen, bar);
            __builtin_amdgcn_fence(__ATOMIC_ACQUIRE, "agent");
            asm volatile("s_waitcnt vmcnt(0)" ::: "memory");
        }
    }
    __syncthreads();
}

struct Args { const void* in[24]; float* out; unsigned char* ws; };
constexpr int XB_ST_OFF = 131072 + 512;
constexpr size_t WS_CTL = 896 * 1024, CTL_BYTES = 16384;
constexpr int PTR_STASH = 131072;
__device__ __forceinline__ const void* ldp(LAS unsigned char* L, int i) { int z = 0; asm volatile("" : "+v"(z)); const unsigned long long v = *(volatile LAS unsigned long long*)(L + PTR_STASH + 8 * i + z);
    const unsigned lo = __builtin_amdgcn_readfirstlane((unsigned)v), hi = __builtin_amdgcn_readfirstlane((unsigned)(v >> 32)); return (const void*)(((unsigned long long)hi << 32) | lo); }

__global__ void __launch_bounds__(NWAVES * 64, 2) fwd_kernel(Args args) {
    extern __shared__ __attribute__((aligned(16))) unsigned char lds[];
    cg::grid_group grid = cg::this_grid();
    LAS unsigned char* L = (LAS unsigned char*)lds;
    const int tid = threadIdx.x, lane = tid & 63, wave = __builtin_amdgcn_readfirstlane(tid >> 6);
    const int G = gridDim.x, bx = blockIdx.x, wave_s = wave;
    if (tid == 0) { LAS unsigned long long* P = (LAS unsigned long long*)(L + PTR_STASH);
#pragma unroll
        for (int i = 0; i < 24; ++i) P[i] = (unsigned long long)args.in[i];
        P[24] = (unsigned long long)args.out; P[25] = (unsigned long long)args.ws; }
    if (tid < 2) ((LAS unsigned*)(L + XB_ST_OFF))[tid] = 0u;
    __syncthreads();
    if (bx == 0) { unsigned* ctl0 = (unsigned*)(args.ws + WS_CTL); for (int i = tid; i < (int)(CTL_BYTES / 4); i += 512) ctl0[i] = 0u; }
#define GRID_BAR() do { XcdBarrier xb_; xb_.bar = (unsigned*)((unsigned char*)ldp(L, 25) + WS_CTL); xb_.x = xb_xcc_id(); xb_.st = (volatile LAS unsigned*)(L + XB_ST_OFF); xcd_barrier(xb_); } while (0)
    const int gw = bx * NWAVES + wave, NGW = G * NWAVES;
    const int gt = bx * 512 + tid, GT = G * 512;
    unsigned char* ws = args.ws;
    const float* x_in = (const float*)args.in[0];
    const float* c_in = (const float*)args.in[1];
    const int* pos_in = (const int*)args.in[2];
    const float* norm_g = (const float*)args.in[3];
    const float* w_ada = (const float*)args.in[4];
    const float* b_ada = (const float*)args.in[5];
    const float* w_in = (const float*)args.in[6];
    const float* w_out = (const float*)args.in[7];
    const float* a_re = (const float*)args.in[8];
    const float* a_im = (const float*)args.in[9];
    const float* b_re = (const float*)args.in[10];
    const float* b_im = (const float*)args.in[11];
    const float* c_re = (const float*)args.in[12];
    const float* c_im = (const float*)args.in[13];
    const float* ssm_d = (const float*)args.in[14];
    const float* log_step = (const float*)args.in[15];
    const float* w_glu = (const float*)args.in[16];
    const float* b_glu = (const float*)args.in[17];
    const float* lam_q1 = (const float*)args.in[18];
    const float* lam_k1 = (const float*)args.in[19];
    const float* lam_q2 = (const float*)args.in[20];
    const float* lam_k2 = (const float*)args.in[21];
    const float* sub_g = (const float*)args.in[22];
    const float* final_g = (const float*)args.in[23];
    float* MOD = (float*)(ws + WS_MOD);
    float* ROPEC = (float*)(ws + WS_ROPEC); float* ROPES = (float*)(ws + WS_ROPES);

    {
        LAS float* cact = (LAS float*)L; LAS float* part = cact + 8 * 2048;
        for (int i = tid; i < 8 * 2048; i += 512) { const float v = c_in[i]; cact[i] = v / (1.f + expf(-v)); }
        __syncthreads();
        for (int task = bx; task < DEPTH * 96; task += G) {
            const int l = task / 96, cb = task % 96;
            const float* w = w_ada + ((size_t)l * 2048 + wave * 256) * 6144 + cb * 64 + lane;
            float a0 = 0.f, a1 = 0.f, a2 = 0.f, a3 = 0.f, a4 = 0.f, a5 = 0.f, a6 = 0.f, a7 = 0.f;
            const LAS float* cw = cact + wave * 256;
#pragma unroll 32
            for (int kk = 0; kk < 256; ++kk) { const float wv = w[(size_t)kk * 6144];
                a0 += cw[kk] * wv; a1 += cw[2048 + kk] * wv; a2 += cw[4096 + kk] * wv; a3 += cw[6144 + kk] * wv;
                a4 += cw[8192 + kk] * wv; a5 += cw[10240 + kk] * wv; a6 += cw[12288 + kk] * wv; a7 += cw[14336 + kk] * wv; }
            LAS float* pw = part + wave * 512 + lane;
            pw[0] = a0; pw[64] = a1; pw[128] = a2; pw[192] = a3; pw[256] = a4; pw[320] = a5; pw[384] = a6; pw[448] = a7;
            __syncthreads();
            { const int b = tid >> 6; float s = b_ada[(size_t)l * 6144 + cb * 64 + lane];
#pragma unroll
              for (int w8 = 0; w8 < 8; ++w8) s += part[w8 * 512 + b * 64 + lane];
              MOD[((size_t)l * 8 + b) * 6144 + cb * 64 + lane] = s; }
            __syncthreads();
        }
    }
    {
        LAS float* ap = (LAS float*)L;
        LAS float* bb = ap + 17 * 64 * 2;
        LAS float* cc = bb + 64 * 16 * 2;
        LAS float* kt = cc + 16 * 64 * 2;
        for (int it = bx; it < DEPTH * 64; it += G) {
            const int l = it >> 6, g = it & 63, lg = it;
            const float step = expf(log_step[lg]);
            for (int idx = tid; idx < 17 * 64; idx += 512) { const int j = idx >> 6, n = idx & 63;
                const float re = a_re[lg * 64 + n], im = a_im[lg * 64 + n];
                const float mag = expf(re * step * (float)j); float s, c; sincos_d((double)im * (double)step * (double)j, s, c);
                ap[idx * 2] = mag * c; ap[idx * 2 + 1] = mag * s; }
            for (int idx = tid; idx < 64 * 16; idx += 512) { const int n = idx >> 4;
                const float re = a_re[lg * 64 + n], im = a_im[lg * 64 + n];
                const float xr = re * step; const float ex = expf(xr), em1 = expm1f(xr);
                float sy, cy, sh, chh; sincos_d((double)im * (double)step, sy, cy); sincos_d(0.5 * (double)im * (double)step, sh, chh);
                const float nr = em1 * cy - 2.f * sh * sh, ni = ex * sy;
                const float den = re * re + im * im, cr = (nr * re + ni * im) / den, ci = (ni * re - nr * im) / den;
                const float br = b_re[(size_t)lg * 1024 + idx], bi = b_im[(size_t)lg * 1024 + idx];
                bb[idx * 2] = cr * br - ci * bi; bb[idx * 2 + 1] = cr * bi + ci * br; }
            for (int idx = tid; idx < 1024; idx += 512) { cc[idx * 2] = c_re[(size_t)lg * 1024 + idx]; cc[idx * 2 + 1] = c_im[(size_t)lg * 1024 + idx]; }
            __syncthreads();
            for (int idx = tid; idx < 4096; idx += 512) { const int j = idx >> 8, p = (idx >> 4) & 15, q = idx & 15; float sum = 0.f;
                for (int n = 0; n < 64; ++n) { const float cr = cc[(p * 64 + n) * 2], ci = cc[(p * 64 + n) * 2 + 1], ar = ap[(j * 64 + n) * 2], ai = ap[(j * 64 + n) * 2 + 1];
                    const float tr = cr * ar - ci * ai, ti = cr * ai + ci * ar; sum += tr * bb[(n * 16 + q) * 2] - ti * bb[(n * 16 + q) * 2 + 1]; }
                if (j == 0 && p == q) sum += ssm_d[lg * 16 + p];
                kt[idx] = sum; }
            __syncthreads();
            bf16* W1 = (bf16*)(ws + WS_S5W + (size_t)l * S5W_LAYER) + (size_t)g * 128 * 256;
            bf16* W2 = (bf16*)(ws + WS_S5W + (size_t)l * S5W_LAYER + S5W2_OFF) + (size_t)g * 256 * 384;
            for (int i2 = tid; i2 < 256 * 192; i2 += 512) { const int row = i2 / 192, c0 = (i2 % 192) * 2, t = row >> 4, p = row & 15; float v[2];
#pragma unroll
                for (int e = 0; e < 2; ++e) { const int col = c0 + e;
                    if (col < 256) { const int tau = col >> 4, q = col & 15; v[e] = (tau <= t) ? kt[((t - tau) << 8) + (p << 4) + q] : 0.f; }
                    else { const int n = (col - 256) & 63; const float cr = cc[(p * 64 + n) * 2], ci = cc[(p * 64 + n) * 2 + 1], ar = ap[((t + 1) * 64 + n) * 2], ai = ap[((t + 1) * 64 + n) * 2 + 1];
                        v[e] = (col < 320) ? (cr * ar - ci * ai) : -(cr * ai + ci * ar); } }
                *(unsigned*)(W2 + (size_t)row * 384 + c0) = pk2(v[0], v[1]); }
            for (int i2 = tid; i2 < 128 * 128; i2 += 512) { const int row = i2 >> 7, c0 = (i2 & 127) * 2, n = row & 63; float v[2];
#pragma unroll
                for (int e = 0; e < 2; ++e) { const int col = c0 + e, tau = col >> 4, p = col & 15;
                    const float ar = ap[((15 - tau) * 64 + n) * 2], ai = ap[((15 - tau) * 64 + n) * 2 + 1], br = bb[(n * 16 + p) * 2], bi = bb[(n * 16 + p) * 2 + 1];
                    v[e] = (row < 64) ? (ar * br - ai * bi) : (ar * bi + ai * br); }
                *(unsigned*)(W1 + (size_t)row * 256 + c0) = pk2(v[0], v[1]); }
            __syncthreads();
        }
    }
    {
        for (int i = gt; i < NTOK * 32; i += GT) { const int j = i & 31; const int p = pos_in[i >> 5];
            const float inv = (float)exp2(-(double)j * (13.287712379549449 / 32.0));
            const float ang = (float)p * inv; float s, c; sincos_d((double)ang, s, c);
            ROPEC[i] = c; ROPES[i] = s; }
    }
    {
        LAS float* scr = (LAS float*)(L + wave * 16384);
        constexpr int I_IN = 32 * 192, I_OUT = 32 * 64, I_GLU = 16 * 64, I_L = I_IN + I_OUT + I_GLU;
        for (int it = gw; it < DEPTH * I_L; it += NGW) {
            const int l = it / I_L; int r = it % I_L;
            if (r < I_IN) { const int kb = r / 192, sb = r % 192; p0_transpose_item(w_in + (size_t)l * 2048 * 6144, 2048, 6144, (bf16*)(ws + WS_WIN) + (size_t)l * 6144 * 2048, win_srccol(sb * 32), sb * 32, kb * 64, scr, lane); continue; }
            r -= I_IN;
            if (r < I_OUT) { const int kb = r / 64, sb = r % 64; p0_transpose_item(w_out + (size_t)l * 2048 * 2048, 2048, 2048, (bf16*)(ws + WS_WOUT) + (size_t)l * 2048 * 2048, sb * 32, sb * 32, kb * 64, scr, lane); continue; }
            r -= I_OUT;
            { const int kb = r / 64, sb = r % 64; p0_transpose_item(w_glu + (size_t)l * 1024 * 2048, 1024, 2048, (bf16*)(ws + WS_WGLU) + (size_t)l * 2048 * 1024, wglu_srccol(sb * 32), sb * 32, kb * 64, scr, lane); }
        }
    }
    grid.sync();
    (void)xcd_barrier_post((unsigned*)((unsigned char*)ldp(L, 25) + WS_CTL), (volatile LAS unsigned*)(L + XB_ST_OFF));

#define PHASE_BEGIN() int zp_ = 0; asm volatile("" : "+v"(zp_)); int wv_ = wave_s, bxp_ = bx; asm volatile("" : "+s"(wv_), "+s"(bxp_)); const int lane = (int)__builtin_amdgcn_mbcnt_hi(~0u, __builtin_amdgcn_mbcnt_lo(~0u, (unsigned)zp_)), wave = wv_; const int tidp = wv_ * 64 + lane; const int gw = bxp_ * NWAVES + wave; unsigned char* ws = (unsigned char*)ldp(L, 25); (void)lane; (void)gw
#define WSP(T, off) ((T*)(ws + (off)))
#define LANE_ID(var) int var; { int z_ = 0; asm volatile("" : "+v"(z_)); var = (int)__builtin_amdgcn_mbcnt_hi(~0u, __builtin_amdgcn_mbcnt_lo(~0u, (unsigned)z_)); }
    {
        PHASE_BEGIN();
        const float* xin = (const float*)ldp(L, 0); const float* gl = (const float*)ldp(L, 3); const float* modl = WSP(const float, WS_MOD);
        bf16* XG = WSP(bf16, WS_H); float* ss0 = WSP(float, WS_SS);
        for (int m0 = gw * 2; m0 < NTOK; m0 += NGW * 2) {
            const int b = m0 >> 12;
            const GASP f32x4* xr = (const GASP f32x4*)(xin + (size_t)m0 * 2048) + lane;
            f32x4 v[2][8]; float s0 = 0.f, s1 = 0.f;
#pragma unroll
            for (int j = 0; j < 8; ++j) { v[0][j] = xr[64 * j]; v[1][j] = xr[512 + 64 * j]; }
#pragma unroll
            for (int j = 0; j < 8; ++j) { s0 += (v[0][j].x * v[0][j].x + v[0][j].y * v[0][j].y) + (v[0][j].z * v[0][j].z + v[0][j].w * v[0][j].w); s1 += (v[1][j].x * v[1][j].x + v[1][j].y * v[1][j].y) + (v[1][j].z * v[1][j].z + v[1][j].w * v[1][j].w); }
            s0 = wave_sum(s0, lane); s1 = wave_sum(s1, lane);
            if (lane == 0) { ((GASP float*)ss0)[m0] = s0; ((GASP float*)ss0)[m0 + 1] = s1; }
#pragma unroll
            for (int j = 0; j < 8; ++j) { const int k = 256 * j + 4 * lane;
                const f32x4 gm = *(const GASP f32x4*)(gl + k) * (*(const GASP f32x4*)(modl + (size_t)b * 6144 + 2048 + k) + 1.f);
                const f32x4 o0 = v[0][j] * gm, o1 = v[1][j] * gm;
                v2u w0, w1; w0.x = pk2(o0.x, o0.y); w0.y = pk2(o0.z, o0.w); w1.x = pk2(o1.x, o1.y); w1.y = pk2(o1.z, o1.w);
                *(GASP v2u*)(XG + (size_t)m0 * 2048 + k) = w0; *(GASP v2u*)(XG + (size_t)(m0 + 1) * 2048 + k) = w1; }
        }
        LAS float* sh = (LAS float*)L;
        for (int ll = 0; ll < DEPTH; ++ll) {
            __syncthreads();
            for (int i = tidp; i < 8 * 512; i += 512) { const int bb = i >> 9, k4 = (i & 511) * 4; *(LAS f32x4*)(sh + bb * 2048 + k4) = *(const GASP f32x4*)(modl + ((size_t)ll * 8 + bb) * 6144 + k4); }
            __syncthreads();
            const bf16* WT = WSP(const bf16, WS_WIN) + (size_t)ll * 6144 * 2048; float* bias = WSP(float, WS_BIAS) + (size_t)ll * 8 * 6144;
            for (int r = gw; r < INW; r += NGW) {
                float a8[8];
#pragma unroll
                for (int bb = 0; bb < 8; ++bb) a8[bb] = 0.f;
#pragma unroll 1
                for (int j = 0; j < 4; ++j) { const int k = j * 512 + lane * 8; const v4u wv = *(const GASP v4u*)(WT + (size_t)r * 2048 + k);
                    const float w0 = bflo(wv.x), w1 = bfhi(wv.x), w2 = bflo(wv.y), w3 = bfhi(wv.y), w4 = bflo(wv.z), w5 = bfhi(wv.z), w6 = bflo(wv.w), w7 = bfhi(wv.w);
#pragma unroll
                    for (int bb = 0; bb < 8; ++bb) { const f32x4 sa = *(const LAS f32x4*)(sh + bb * 2048 + k), sb = *(const LAS f32x4*)(sh + bb * 2048 + k + 4);
                        a8[bb] += (sa.x * w0 + sa.y * w1) + (sa.z * w2 + sa.w * w3) + (sb.x * w4 + sb.y * w5) + (sb.z * w6 + sb.w * w7); } }
#pragma unroll
                for (int bb = 0; bb < 8; ++bb) { const float s = wave_sum(a8[bb], lane); if (lane == 0) ((GASP float*)bias)[(size_t)bb * 6144 + r] = s; }
            }
        }
    }
    GRID_BAR();
    for (int l = 0; l < DEPTH; ++l) {
        {
            PHASE_BEGIN();
            pg8::Gemm g{WSP(const bf16, WS_H), WSP(const bf16, WS_WIN) + (size_t)l * 6144 * 2048, NTOK, INW, 2048, 2048, 2048, 1 << 30, 0};
            pg8::StaticOrder S; S.init(NTOK, INW, G, bx);
            pg8::EpiInProj Ep{ws, l};
            pg8::gemm_phase<pg8::EpiInProj, pg8::StaticOrder, true, true>(L, g, S, Ep, tidp);
        }
        GRID_BAR();
        {
            PHASE_BEGIN();
            pg8::Gemm g{WSP(const bf16, WS_A2), WSP(const bf16, WS_S5W + (size_t)l * S5W_LAYER), 64 * 2048, 256, 256, pg8::A2_LD, 256, 8, 128};
            pg8::StaticOrder S; S.init(64 * 2048, 256, G, bx);
            pg8::EpiS5P1 Ep{ws};
            pg8::gemm_phase<pg8::EpiS5P1, pg8::StaticOrder, true, true>(L, g, S, Ep, tidp);
        }
        asm volatile("s_waitcnt vmcnt(0) lgkmcnt(0)" ::: "memory"); __syncthreads();
        {
            PHASE_BEGIN();
            LAS float* tot = (LAS float*)L;
            { float* ssz = WSP(float, WS_SS) + ((l + 1) & 1) * 32768; for (int i = bx * 512 + tidp; i < 32768; i += G * 512) ((GASP float*)ssz)[i] = 0.f; }
            const float* log_step = (const float*)ldp(L, 15); const float* a_re = (const float*)ldp(L, 8); const float* a_im = (const float*)ldp(L, 9);
            const float* E = WSP(const float, WS_H); bf16* A2 = WSP(bf16, WS_A2);
            pg8::StaticOrder SO; SO.init(64 * 2048, 256, G, bx);
            pg8::Unit su;
            for (int ui = 0; SO.next(ui, su); ++ui) {
                const int b = su.pm & 7, g = su.pm >> 3, n = lane, seg = wave, lg = l * 64 + g;
                const float step = expf(log_step[lg]); const float re = a_re[lg * 64 + n], im = a_im[lg * 64 + n];
                float aLr, aLi; { const float mag = expf(re * step * 16.f); float s, c; sincos_d((double)im * (double)step * 16.0, s, c); aLr = mag * c; aLi = mag * s; }
                const GASP float* Ep = (const GASP float*)(E + ((size_t)(g * 2048 + b * 256 + seg * 32)) * 128 + n);
                float hr[32], hi[32]; float sr = 0.f, si = 0.f;
#pragma unroll
                for (int j = 0; j < 32; ++j) { const float er = Ep[(size_t)j * 128], ei = Ep[(size_t)j * 128 + 64];
                    const float tr = aLr * sr - aLi * si + er, ti = aLr * si + aLi * sr + ei; sr = tr; si = ti; hr[j] = sr; hi[j] = si; }
                tot[(seg * 64 + n) * 2] = sr; tot[(seg * 64 + n) * 2 + 1] = si;
                float pr = aLr, pi = aLi;
#pragma unroll
                for (int q = 0; q < 5; ++q) { const float tr = pr * pr - pi * pi, ti = 2.f * pr * pi; pr = tr; pi = ti; }
                __syncthreads();
                float cr = 0.f, ci = 0.f;
                for (int s2 = 0; s2 < seg; ++s2) { const float tr = pr * cr - pi * ci + tot[(s2 * 64 + n) * 2], ti = pr * ci + pi * cr + tot[(s2 * 64 + n) * 2 + 1]; cr = tr; ci = ti; }
                GASP bf16* Ap = (GASP bf16*)(A2 + ((size_t)(g * 2048 + b * 256 + seg * 32)) * pg8::A2_LD + 256 + n);
#pragma unroll
                for (int j = 0; j < 32; ++j) { const float vr = cr + (j ? hr[j - 1] : 0.f), vi = ci + (j ? hi[j - 1] : 0.f);
                    Ap[(size_t)j * pg8::A2_LD] = (bf16)f2bf(vr); Ap[(size_t)j * pg8::A2_LD + 64] = (bf16)f2bf(vi);
                    const float tr = aLr * cr - aLi * ci, ti = aLr * ci + aLi * cr; cr = tr; ci = ti; }
                __syncthreads();
            }
        }
        asm volatile("s_waitcnt vmcnt(0) lgkmcnt(0)" ::: "memory"); __syncthreads();
        {
            PHASE_BEGIN();
            pg8::Gemm g{WSP(const bf16, WS_A2), WSP(const bf16, WS_S5W + (size_t)l * S5W_LAYER + S5W2_OFF), 64 * 2048, 256, 384, pg8::A2_LD, 384, 8, 256};
            pg8::StaticOrder S; S.init(64 * 2048, 256, G, bx);
            pg8::EpiS5P2 Ep{ws};
            pg8::gemm_phase<pg8::EpiS5P2, pg8::StaticOrder, true, true>(L, g, S, Ep, tidp);
        }
        GRID_BAR();
        {
            PHASE_BEGIN();
            pg8::Gemm g{WSP(const bf16, WS_E), WSP(const bf16, WS_WGLU) + (size_t)l * 2048 * 1024, NTOK, 2048, 1024, 1024, 1024, 1 << 30, 0};
            pg8::StaticOrder S; S.init(NTOK, 2048, G, bx);
            pg8::EpiGlu Ep{ws, (const float*)ldp(L, 17) + (size_t)l * 2048};
            pg8::gemm_phase<pg8::EpiGlu, pg8::StaticOrder, true, true>(L, g, S, Ep, tidp);
        }
        {
            PHASE_BEGIN();
            const int vcu = (G % 8 == 0) ? (bx % 8) * (G / 8) + bx / 8 : bx;
            for (int grp = vcu; grp < 256; grp += G) {
                const int b = grp >> 5, h = (grp >> 2) & 7, s4 = grp & 3;
                for (int cm = 0; cm < 4; ++cm) { const int mp = cm >> 1, vh = cm & 1;
                    for (int qi = 0; qi < 4; ++qi) {
                        const int qb = (qi == 0) ? 15 - s4 : (qi == 1) ? 8 + s4 : (qi == 2) ? 7 - s4 : s4;
                        int t2 = tidp; asm volatile("" : "+v"(t2));
                        unsigned char* w2 = ws; asm volatile("" : "+s"(w2));
                        attn_body::attn_unit<8>(b, (h * 2 + mp) * 64, h * 128 + vh * 64, qb, (const attn_body::bf16*)(w2 + WS_Q), (const attn_body::bf16*)(w2 + WS_K), (const attn_body::bf16*)(w2 + WS_V),
                                                (attn_body::bf16*)(w2 + WS_H) + (mp ? (size_t)NTOK * 1024 : 0), (char*)lds, t2); } }
                for (int qi = 0; qi < 4; ++qi) {
                    const int qb = (qi == 0) ? 15 - s4 : (qi == 1) ? 8 + s4 : (qi == 2) ? 7 - s4 : s4;
                    {
                        asm volatile("s_waitcnt vmcnt(0)" ::: "memory");
                        int ln = tidp & 63; asm volatile("" : "+v"(ln));
                        unsigned char* w2 = ws; asm volatile("" : "+s"(w2));
                        const float lambda_init = 0.8f - 0.6f * expf(-0.3f * (float)l);
                        const float* lq1 = (const float*)ldp(L, 18); const float* lk1 = (const float*)ldp(L, 19); const float* lq2 = (const float*)ldp(L, 20); const float* lk2 = (const float*)ldp(L, 21);
                        const float d1 = wave_sum(lq1[l * 64 + ln] * lk1[l * 64 + ln], ln), d2 = wave_sum(lq2[l * 64 + ln] * lk2[l * 64 + ln], ln);
                        const float lam = expf(d1) - expf(d2) + lambda_init;
                        const int c8 = (ln & 15) * 8, sub = ln >> 4;
                        const float* sg = (const float*)ldp(L, 22) + (size_t)l * 128 + c8;
                        const f32x4 sg0 = *(const GASP f32x4*)sg * (1.f - lambda_init), sg1 = *(const GASP f32x4*)(sg + 4) * (1.f - lambda_init);
                        const size_t r0 = (size_t)b * SEQ + qb * 256 + wave * 32 + sub;
                        const bf16* O1 = (const bf16*)(w2 + WS_H); const bf16* O2 = O1 + (size_t)NTOK * 1024; const bf16* ZA = (const bf16*)(w2 + WS_ZA); bf16* YCAT = (bf16*)(w2 + WS_A2);
                        v4u pp[8], qq[8], zz[8];
#pragma unroll
                        for (int it = 0; it < 8; ++it) { const size_t off = (r0 + it * 4) * 1024 + h * 128 + c8;
                            pp[it] = *(const GASP v4u*)(O1 + off); qq[it] = *(const GASP v4u*)(O2 + off);
                            zz[it] = *(const GASP v4u*)(ZA + off); }
#pragma unroll
                        for (int it = 0; it < 8; ++it) { const size_t row = r0 + it * 4; const v4u p = pp[it], q = qq[it], z = zz[it];
                            float d[8]; float ss = 0.f;
#pragma unroll
                            for (int e = 0; e < 4; ++e) { d[2 * e] = bflo(p[e]) - lam * bflo(q[e]); d[2 * e + 1] = bfhi(p[e]) - lam * bfhi(q[e]); ss += d[2 * e] * d[2 * e] + d[2 * e + 1] * d[2 * e + 1]; }
                            ss += lane_xor(ss, ln, 1); ss += lane_xor(ss, ln, 2); ss += lane_xor(ss, ln, 4); ss += lane_xor(ss, ln, 8);
                            const float r = 1.0f / sqrtf(ss * (1.f / 128.f) + 1e-6f);
                            v4u o;
                            o[0] = pk2(d[0] * r * sg0[0] * bflo(z[0]), d[1] * r * sg0[1] * bfhi(z[0])); o[1] = pk2(d[2] * r * sg0[2] * bflo(z[1]), d[3] * r * sg0[3] * bfhi(z[1]));
                            o[2] = pk2(d[4] * r * sg1[0] * bflo(z[2]), d[5] * r * sg1[1] * bfhi(z[2])); o[3] = pk2(d[6] * r * sg1[2] * bflo(z[3]), d[7] * r * sg1[3] * bfhi(z[3]));
                            *(GASP v4u*)(YCAT + row * 2048 + 1024 + h * 128 + c8) = o; }
                    }
                }
            }
        }
        GRID_BAR();
        {
            PHASE_BEGIN();
            pg8::Gemm g{WSP(const bf16, WS_A2), WSP(const bf16, WS_WOUT) + (size_t)l * 2048 * 2048, NTOK, 2048, 2048, 2048, 2048, 1 << 30, 0};
            pg8::StaticOrder S; S.init(NTOK, 2048, G, bx);
            pg8::EpiOut Ep{(l == 0) ? (const float*)ldp(L, 0) : (const float*)ldp(L, 24), (float*)ldp(L, 24), ws, (const float*)ldp(L, 3) + (size_t)(l < 3 ? l + 1 : 0) * 2048, l};
            pg8::gemm_phase<pg8::EpiOut, pg8::StaticOrder, true, true>(L, g, S, Ep, tidp);
        }
        GRID_BAR();
    }
    {
        PHASE_BEGIN();
        float* xres = (float*)ldp(L, 24); const float* final_g = (const float*)ldp(L, 23); (void)ws;
        for (int m = gw; m < NTOK; m += NGW) {
            GASP f32x4* xr = (GASP f32x4*)(xres + (size_t)m * 2048) + lane;
            f32x4 v[8]; float s = 0.f;
#pragma unroll
            for (int j = 0; j < 8; ++j) { v[j] = xr[64 * j]; s += (v[j].x * v[j].x + v[j].y * v[j].y) + (v[j].z * v[j].z + v[j].w * v[j].w); }
            const float r = 1.0f / sqrtf(wave_sum(s, lane) * (1.f / 2048.f) + 1e-6f);
#pragma unroll
            for (int j = 0; j < 8; ++j) { const f32x4 gg = *(const GASP f32x4*)(final_g + 256 * j + 4 * lane); xr[64 * j] = (v[j] * r) * gg; }
        }
    }
}

extern "C" void kernel_launch(void* const* d_in, const int* in_sizes, int n_in, void* d_out, int out_size, void* d_ws, size_t ws_size, hipStream_t stream) {
    static int grid = 0;
    if (grid == 0) {
        if (n_in != 24 || out_size != NTOK * DMODEL || ws_size < WS_END) { fprintf(stderr, "kernel_launch: unexpected shapes (n_in %d out %d ws %zu); nothing launched\n", n_in, out_size, ws_size); grid = -1; return; }
        int dev = 0, cus = 0, per_cu = 0;
        if (hipGetDevice(&dev) != hipSuccess || hipDeviceGetAttribute(&cus, hipDeviceAttributeMultiprocessorCount, dev) != hipSuccess) { grid = -1; return; }
        if (hipFuncSetAttribute((const void*)fwd_kernel, hipFuncAttributeMaxDynamicSharedMemorySize, LDS_BYTES) != hipSuccess) { fprintf(stderr, "kernel_launch: hipFuncSetAttribute failed\n"); grid = -1; return; }
        if (hipOccupancyMaxActiveBlocksPerMultiprocessor(&per_cu, (const void*)fwd_kernel, NWAVES * 64, LDS_BYTES) != hipSuccess || per_cu < 1) { fprintf(stderr, "kernel_launch: occupancy query says %d blocks per CU\n", per_cu); per_cu = 1; }
        (void)hipGetLastError();
        grid = cus;
    }
    if (grid < 0) return;
    Args a{};
    for (int i = 0; i < 24; ++i) a.in[i] = d_in[i];
    a.out = (float*)d_out; a.ws = (unsigned char*)d_ws;
    void* kargs[] = {&a};
    const hipError_t e = hipLaunchCooperativeKernel((const void*)fwd_kernel, dim3(grid), dim3(NWAVES * 64), kargs, LDS_BYTES, stream);
    if (e != hipSuccess) fprintf(stderr, "kernel_launch: cooperative launch failed: %s (grid %d)\n", hipGetErrorString(e), grid);
}
```
